# Optimizing an MI355X kernel written in HIP

```python
import math
import jax, jax.numpy as jnp
from jax import lax
import numpy as np

D_MODEL = 1024
BATCH = 8
SEQ = 4096
DEPTH = 2

CHUNK = 64
MEM_LEN = 256
N_MIXERS = 2
N_A = (DEPTH + 1) // 2
N_B = DEPTH // 2

D_LRU = D_MODEL // 2
LRU_BLOCKS = 8
LRU_BLK = D_LRU // LRU_BLOCKS
CONV_WIDTH = 4
LRU_C = 8.0

FOX_HEADS = 8
FOX_HD = 64
FOX_WIDTH = FOX_HEADS * FOX_HD
Q_BLOCK = 128

XA_HEADS = 4
XA_HD = 128
XA_WIDTH = XA_HEADS * XA_HD

D_FF = 4 * D_MODEL
EPS = 1e-6
NEG_INF = -1e30

kernel_name = "hybrid_rglru_fox_memxattn_trunk"


def rms_norm(x, g):
    xf = x.astype(jnp.float32)
    y = xf * lax.rsqrt(jnp.mean(xf * xf, axis=-1, keepdims=True) + EPS)
    return (y * g.astype(jnp.float32)).astype(x.dtype)


def _lin_combine(left, right):
    a1, b1 = left
    a2, b2 = right
    return a1 * a2, a2 * b1 + b2


def rglru_group(h, w_in, conv_w, conv_b, w_r, b_r, w_i, b_i, lam):
    B, S, _ = h.shape
    proj = h @ w_in
    u, gate, xq = jnp.split(proj, [D_LRU, 2 * D_LRU], axis=-1)
    u = lax.conv_general_dilated(
        u, conv_w[:, None, :].astype(u.dtype), window_strides=(1,),
        padding=[(CONV_WIDTH - 1, 0)], dimension_numbers=("NWC", "WIO", "NWC"),
        feature_group_count=D_LRU) + conv_b
    ub = u.reshape(B, S, LRU_BLOCKS, LRU_BLK)
    r = jax.nn.sigmoid(jnp.einsum("bsnc,ncd->bsnd", ub, w_r).reshape(B, S, D_LRU) + b_r)
    i = jax.nn.sigmoid(jnp.einsum("bsnc,ncd->bsnd", ub, w_i).reshape(B, S, D_LRU) + b_i)
    log_a = -LRU_C * r.astype(jnp.float32) * jax.nn.softplus(-lam.astype(jnp.float32))
    a = jnp.exp(log_a)
    b = jnp.sqrt(-jnp.expm1(2.0 * log_a)) * (i.astype(jnp.float32) * u.astype(jnp.float32))
    _, hs = lax.associative_scan(_lin_combine, (a, b), axis=1)
    y = hs.astype(h.dtype) * jax.nn.gelu(gate, approximate=True)
    return y, xq


def fox_group(h, w_in, b_f, q_gain, k_gain):
    B, S, _ = h.shape
    n_qb = S // Q_BLOCK
    proj = h @ w_in
    q, k, v, f_logit, xq = jnp.split(
        proj, [FOX_WIDTH, 2 * FOX_WIDTH, 3 * FOX_WIDTH, 3 * FOX_WIDTH + FOX_HEADS], axis=-1)
    q = rms_norm(q.reshape(B, S, FOX_HEADS, FOX_HD), q_gain)
    k = rms_norm(k.reshape(B, S, FOX_HEADS, FOX_HD), k_gain)
    v = v.reshape(B, S, FOX_HEADS, FOX_HD)
    log_f = jax.nn.log_sigmoid(f_logit.astype(jnp.float32) + b_f.astype(jnp.float32))
    c = jnp.cumsum(log_f, axis=1).transpose(0, 2, 1)
    kh = k.transpose(0, 2, 1, 3)
    vh = v.transpose(0, 2, 1, 3)
    q_blocks = q.reshape(B, n_qb, Q_BLOCK, FOX_HEADS, FOX_HD).transpose(1, 0, 3, 2, 4)
    c_blocks = c.reshape(B, FOX_HEADS, n_qb, Q_BLOCK).transpose(2, 0, 1, 3)
    q_pos = jnp.arange(S, dtype=jnp.int32).reshape(n_qb, Q_BLOCK)
    k_pos = jnp.arange(S, dtype=jnp.int32)
    scale = 1.0 / math.sqrt(FOX_HD)

    def one_block(args):
        qb, cb, pos = args
        s = jnp.einsum("bhqd,bhkd->bhqk", qb, kh).astype(jnp.float32) * scale
        s = s + cb[..., :, None] - c[:, :, None, :]
        s = jnp.where(pos[:, None] >= k_pos[None, :], s, NEG_INF)
        p = jax.nn.softmax(s, axis=-1)
        return jnp.einsum("bhqk,bhkd->bhqd", p.astype(vh.dtype), vh)

    o = lax.map(one_block, (q_blocks, c_blocks, q_pos))
    o = o.transpose(1, 0, 3, 2, 4).reshape(B, S, FOX_WIDTH)
    return o, xq


def memory_group(xq, mem, g_mem, w_kv, q_gain, k_gain):
    B, S, _ = xq.shape
    M = mem.shape[1]
    kv = rms_norm(mem, g_mem) @ w_kv
    k, v = jnp.split(kv, [XA_WIDTH], axis=-1)
    q = rms_norm(xq.reshape(B, S, XA_HEADS, XA_HD), q_gain)
    k = rms_norm(k.reshape(B, M, XA_HEADS, XA_HD), k_gain)
    v = v.reshape(B, M, XA_HEADS, XA_HD)
    s = jnp.einsum("bshd,bmhd->bhsm", q, k).astype(jnp.float32) * (1.0 / math.sqrt(XA_HD))
    p = jax.nn.softmax(s, axis=-1)
    o = jnp.einsum("bhsm,bmhd->bshd", p.astype(v.dtype), v)
    return o.reshape(B, S, XA_WIDTH)


def sqrelu_mlp(h, w1, w2):
    return jnp.square(jax.nn.relu(h @ w1)) @ w2


def setup_inputs(seed: int = 0) -> dict:
    key = jax.random.key(seed)
    ks = jax.random.split(key, 32)
    f32 = jnp.float32

    def nrm(k, shape, fan_in):
        return jax.random.normal(k, shape, f32) * (fan_in ** -0.5)

    def gain(k, shape):
        return 1.0 + 0.05 * jax.random.normal(k, shape, f32)

    def small(k, shape):
        return 0.02 * jax.random.normal(k, shape, f32)

    x = jax.random.normal(ks[0], (BATCH, SEQ, D_MODEL), f32)
    mem = jax.random.normal(ks[1], (BATCH, MEM_LEN, D_MODEL), f32)
    a_c = jax.random.uniform(ks[2], (N_A, D_LRU), f32, 0.9, 0.999)
    s_lam = a_c ** (1.0 / LRU_C)
    lru_lambda = jnp.log(s_lam) - jnp.log1p(-s_lam)
    return {
        "x": x,
        "mem": mem,
        "norm_mix": gain(ks[3], (DEPTH, D_MODEL)),
        "norm_mem": gain(ks[4], (DEPTH, D_MODEL)),
        "w_mem_kv": nrm(ks[5], (DEPTH, D_MODEL, 2 * XA_WIDTH), D_MODEL),
        "xa_q_gain": gain(ks[6], (DEPTH, XA_HD)),
        "xa_k_gain": gain(ks[7], (DEPTH, XA_HD)),
        "w_out": nrm(ks[8], (DEPTH, D_LRU + XA_WIDTH, D_MODEL), D_LRU + XA_WIDTH),
        "norm_mlp": gain(ks[9], (DEPTH, D_MODEL)),
        "w_mlp_in": nrm(ks[10], (DEPTH, D_MODEL, D_FF), D_MODEL),
        "w_mlp_out": nrm(ks[11], (DEPTH, D_FF, D_MODEL), D_FF),
        "w_in_a": nrm(ks[12], (N_A, D_MODEL, 2 * D_LRU + XA_WIDTH), D_MODEL),
        "conv_w": nrm(ks[13], (N_A, CONV_WIDTH, D_LRU), CONV_WIDTH),
        "conv_b": small(ks[14], (N_A, D_LRU)),
        "w_rgate": nrm(ks[15], (N_A, LRU_BLOCKS, LRU_BLK, LRU_BLK), LRU_BLK),
        "b_rgate": small(ks[16], (N_A, D_LRU)),
        "w_igate": nrm(ks[17], (N_A, LRU_BLOCKS, LRU_BLK, LRU_BLK), LRU_BLK),
        "b_igate": small(ks[18], (N_A, D_LRU)),
        "lru_lambda": lru_lambda,
        "w_in_b": nrm(ks[19], (N_B, D_MODEL, 3 * FOX_WIDTH + FOX_HEADS + XA_WIDTH), D_MODEL),
        "b_forget": jax.random.uniform(ks[20], (N_B, FOX_HEADS), f32, 1.0, 6.0),
        "fox_q_gain": gain(ks[21], (N_B, FOX_HD)),
        "fox_k_gain": gain(ks[22], (N_B, FOX_HD)),
    }


def reference(x, mem, norm_mix, norm_mem, w_mem_kv, xa_q_gain, xa_k_gain, w_out,
              norm_mlp, w_mlp_in, w_mlp_out, w_in_a, conv_w, conv_b, w_rgate, b_rgate,
              w_igate, b_igate, lru_lambda, w_in_b, b_forget, fox_q_gain, fox_k_gain):
    for layer in range(DEPTH):
        h = rms_norm(x, norm_mix[layer])
        j = layer // N_MIXERS
        if layer % N_MIXERS == 0:
            y_mix, xq = rglru_group(h, w_in_a[j], conv_w[j], conv_b[j], w_rgate[j], b_rgate[j],
                                    w_igate[j], b_igate[j], lru_lambda[j])
        else:
            y_mix, xq = fox_group(h, w_in_b[j], b_forget[j], fox_q_gain[j], fox_k_gain[j])
        y_mem = memory_group(xq, mem, norm_mem[layer], w_mem_kv[layer],
                             xa_q_gain[layer], xa_k_gain[layer])
        x = x + jnp.concatenate([y_mix, y_mem], axis=-1) @ w_out[layer]
        x = x + sqrelu_mlp(rms_norm(x, norm_mlp[layer]), w_mlp_in[layer], w_mlp_out[layer])
    return x
```

```cpp
#include <hip/hip_runtime.h>
#include <hip/hip_cooperative_groups.h>
#include <cstdio>
#include <cstdint>
namespace cg = cooperative_groups;
#ifndef MK_MULTI
#define MK_MULTI 0
#endif
namespace pg8 {
#define PG8_LAS __attribute__((address_space(3)))
typedef unsigned short bf16_t;
typedef short bf16x8 __attribute__((ext_vector_type(8)));
typedef float f32x4 __attribute__((ext_vector_type(4)));
typedef unsigned u32x4 __attribute__((ext_vector_type(4)));
constexpr int BM = 256, BK = 64, HALF = 128, HTB = HALF * BK * 2  , STAGE_BYTES = 8 * HTB, NXCD = 8, WGM = 8;

__host__ __device__ __forceinline__ int lds_byte(int r, int c) { const int st = (r >> 4) * 2 + (c >> 5), rr = r & 15, cc = c & 31, ob = rr * 64 + cc * 2; return st * 1024 + (ob ^ (((ob >> 9) & 1) << 5)); }
__host__ __device__ __forceinline__ void stage_rc(int b, int& R, int& C) { const int st = b / 1024, sb = b % 1024, swz = sb ^ (((sb >> 9) & 1) << 5); R = (st >> 1) * 16 + swz / 64; C = (st & 1) * 32 + (swz % 64) / 2; }
__host__ __device__ __forceinline__ int perm32(int rho) { const int n = rho >> 4, i = rho & 15; return 8 * (i >> 2) + 4 * n + (i & 3); }

struct Unit { int pm, pn; };
struct Gemm { const bf16_t* A; const bf16_t* Bt; int M, N, K; };

struct StaticOrder {
    int nM, nN, nwg, G, c;
    __host__ __device__ void init(int M, int N, int G_, int c_) { nM = M / BM; nN = N / BM; nwg = nM * nN; G = G_; c = c_; }
    __host__ __device__ bool next(int i, Unit& u) const {
        const long L = (long)i * G + c; if (L >= nwg) return false;
        int wgid = (int)L; { const int q = nwg / NXCD, r = nwg % NXCD, xcd = wgid % NXCD, off = wgid / NXCD; wgid = (xcd < r ? xcd * (q + 1) : r * (q + 1) + (xcd - r) * q) + off; }
        const int nig = WGM * nN, gid = wgid / nig, fm = gid * WGM, gsz = (nM - fm) < WGM ? (nM - fm) : WGM;
        u.pm = fm + ((wgid % nig) % gsz); u.pn = (wgid % nig) / gsz; return true;
    }
    __device__ __forceinline__ void a_ready(const Unit&) const {}
    __device__ __forceinline__ void done(const Unit&) const {}
};

__device__ __forceinline__ unsigned cvt_pk_bf16(float lo, float hi) { unsigned r; asm volatile("v_cvt_pk_bf16_f32 %0, %1, %2" : "=v"(r) : "v"(lo), "v"(hi)); return r; }
typedef float f32x2 __attribute__((ext_vector_type(2)));
typedef float f32x2 __attribute__((ext_vector_type(2)));
typedef unsigned u32x2 __attribute__((ext_vector_type(2)));
__device__ __forceinline__ float gelu_tanh_f(float x) {
    const float z = 0.7978845608028654f * (x + 0.044715f * x * x * x);
    const float e = __builtin_amdgcn_exp2f(-2.0f * 1.4426950408889634f * z);
    return x * __builtin_amdgcn_rcpf(1.0f + e);
}
template <int ACT  > struct EpiAct {
    static constexpr bool PERM = true, AFTER_DRAIN = false;
    bf16_t* O; int ldc; const float* ssp; float inv_n; float eps;
    __device__ __forceinline__ void operator()(const f32x4 (&acc)[2][2][4][2], const Unit& u, int wr, int wc, int fr, int fq) const {
        const int row0 = u.pm * BM + wr * 64 + fr, col0 = u.pn * BM + wc * 32 + 8 * fq;
        const bool gel = (ACT == 1) && (u.pn >= 2) && (u.pn < 4);
#pragma unroll
        for (int ai = 0; ai < 2; ++ai)
#pragma unroll
            for (int m = 0; m < 4; ++m) {
                const int row = row0 + ai * HALF + m * 16;
                const f32x4* sp = (const f32x4*)(ssp + (size_t)row * 16);
                const f32x4 s0 = sp[0], s1 = sp[1], s2 = sp[2], s3 = sp[3];
                const float ss = ((s0[0] + s0[1]) + (s0[2] + s0[3])) + ((s1[0] + s1[1]) + (s1[2] + s1[3])) + ((s2[0] + s2[1]) + (s2[2] + s2[3])) + ((s3[0] + s3[1]) + (s3[2] + s3[3]));
                const float rs = 1.0f / sqrtf(ss * inv_n + eps);
                bf16_t* rowp = O + (size_t)row * ldc + col0;
#pragma unroll
                for (int bj = 0; bj < 2; ++bj) {
                    f32x4 v0 = acc[ai][bj][m][0] * rs, v1 = acc[ai][bj][m][1] * rs;
                    if (ACT == 1) { if (gel) {
#pragma unroll
                        for (int e = 0; e < 4; ++e) { v0[e] = gelu_tanh_f(v0[e]); v1[e] = gelu_tanh_f(v1[e]); } } }
                    if (ACT == 2) {
#pragma unroll
                        for (int e = 0; e < 4; ++e) { const float a = fmaxf(v0[e], 0.f), b = fmaxf(v1[e], 0.f); v0[e] = a * a; v1[e] = b * b; } }
                    u32x4 w; w.x = cvt_pk_bf16(v0[0], v0[1]); w.y = cvt_pk_bf16(v0[2], v0[3]); w.z = cvt_pk_bf16(v1[0], v1[1]); w.w = cvt_pk_bf16(v1[2], v1[3]);
                    *(u32x4*)(rowp + bj * HALF) = w; }
            }
    }
};
struct EpiRes {
    static constexpr bool PERM = false, AFTER_DRAIN = false;
    const float* base; float* out; bf16_t* xb; float* ssp; int ldc;
    __device__ __forceinline__ void operator()(const f32x4 (&acc)[2][2][4][2], const Unit& u, int wr, int wc, int fr, int fq) const {
        const int row0 = u.pm * BM + wr * 64 + fr, col0 = u.pn * BM + wc * 32 + 4 * fq;
#pragma unroll
        for (int ai = 0; ai < 2; ++ai)
#pragma unroll
            for (int m = 0; m < 4; ++m) {
                const int row = row0 + ai * HALF + m * 16; const size_t off = (size_t)row * ldc + col0; float ss = 0.f;
#pragma unroll
                for (int bj = 0; bj < 2; ++bj)
#pragma unroll
                    for (int n = 0; n < 2; ++n) {
                        const f32x4 bs = *(const f32x4*)(base + off + bj * HALF + n * 16); const f32x4 v = bs + acc[ai][bj][m][n];
                        *(f32x4*)(out + off + bj * HALF + n * 16) = v;
                        ss += (v[0] * v[0] + v[1] * v[1]) + (v[2] * v[2] + v[3] * v[3]);
                        u32x2 w; w.x = cvt_pk_bf16(v[0], v[1]); w.y = cvt_pk_bf16(v[2], v[3]); *(u32x2*)(xb + off + bj * HALF + n * 16) = w; }
                ss += __shfl_xor(ss, 16); ss += __shfl_xor(ss, 32);
                if (fq == 0) ssp[(size_t)row * 16 + u.pn * 4 + wc] = ss;
            }
    }
};
template <class Epi, class Sched, bool ALIGN_EPI = false, bool SP2 = false>
__device__ __forceinline__ void gemm_phase(PG8_LAS unsigned char* lds, const Gemm g, const Sched& S, const Epi& E) {
    const int tid = threadIdx.x, wid = __builtin_amdgcn_readfirstlane(tid >> 6), lane = tid & 63, wr = wid >> 2, wc = wid & 3, fr = lane & 15, fq = lane >> 4;
    const int K = g.K, nt = K / BK;
    unsigned voffA[2], voffB[2];
#pragma unroll
    for (int i = 0; i < 2; ++i) { int R, C; stage_rc(tid * 16 + i * 8192, R, C); const int Rb = Epi::PERM ? ((R & ~31) + perm32(R & 31)) : R;
        voffA[i] = (unsigned)(R * K + C) * 2u; voffB[i] = (unsigned)(Rb * K + C) * 2u; }
    const size_t kstep = (size_t)(BK * 2);
    const size_t hstep = (size_t)HALF * K * 2;
    const size_t tstep = 2 * hstep;
    const unsigned ldsw = (unsigned)wid * 1024u;
    const int aoff = lds_byte(wr * 64 + fr, fq * 8), boff = lds_byte(wc * 32 + fr, fq * 8);
#define PG8_SA(b, h) (((b) * 2 + (h)) * HTB)
#define PG8_SB(b, h) ((4 + (b) * 2 + (h)) * HTB)
#define PG8_STAGE(bufoff, gbase, voff) do { _Pragma("unroll") for (int _i = 0; _i < 2; ++_i) \
        __builtin_amdgcn_global_load_lds((const unsigned*)((const char*)(gbase) + (voff)[_i]), (PG8_LAS unsigned*)(lds + (bufoff) + ldsw + _i * 8192), 16, 0, 0); } while (0)
#define PG8_LDA(dst, b, h) do { _Pragma("unroll") for (int m = 0; m < 4; ++m) _Pragma("unroll") for (int k = 0; k < 2; ++k) dst[m][k] = *(const PG8_LAS bf16x8*)(lds + PG8_SA(b, h) + aoff + m * 2048 + k * 1024); } while (0)
#define PG8_LDB(dst, b, h) do { _Pragma("unroll") for (int n = 0; n < 2; ++n) _Pragma("unroll") for (int k = 0; k < 2; ++k) dst[n][k] = *(const PG8_LAS bf16x8*)(lds + PG8_SB(b, h) + boff + n * 2048 + k * 1024); } while (0)
#define PG8_MMA(ai, bj, At, Bt) do { __builtin_amdgcn_s_setprio(1); _Pragma("unroll") for (int m = 0; m < 4; ++m) _Pragma("unroll") for (int n = 0; n < 2; ++n) _Pragma("unroll") for (int k = 0; k < 2; ++k) \
        acc[ai][bj][m][n] = __builtin_amdgcn_mfma_f32_16x16x32_bf16(Bt[n][k], At[m][k], acc[ai][bj][m][n], 0, 0, 0); __builtin_amdgcn_s_setprio(0); } while (0)
#define PG8_WAIT_V(n) asm volatile("s_waitcnt vmcnt(" #n ")" ::: "memory")
#define PG8_WAIT_L(n) asm volatile("s_waitcnt lgkmcnt(" #n ")" ::: "memory")
#define PG8_BAR __builtin_amdgcn_s_barrier()
#define PG8_SCHED __builtin_amdgcn_sched_barrier(0)
    Unit cur, nxt; int ui = 0;
    if (!S.next(0, cur)) return;
    f32x4 acc[2][2][4][2];
#pragma unroll
    for (int a = 0; a < 2; ++a)
#pragma unroll
        for (int b = 0; b < 2; ++b)
#pragma unroll
            for (int m = 0; m < 4; ++m)
#pragma unroll
                for (int n = 0; n < 2; ++n) acc[a][b][m][n] = (f32x4){0.f, 0.f, 0.f, 0.f};
    bf16x8 At[4][2], B0[2][2], B1[2][2];
    const char* cA = (const char*)g.A + (size_t)cur.pm * tstep; const char* cB = (const char*)g.Bt + (size_t)cur.pn * tstep;
    S.a_ready(cur);
    if constexpr (SP2) {
        PG8_STAGE(PG8_SB(0, 0), cB, voffB); PG8_STAGE(PG8_SB(0, 1), cB + hstep, voffB); PG8_STAGE(PG8_SA(0, 0), cA, voffA); PG8_STAGE(PG8_SA(0, 1), cA + hstep, voffA);
        if (wr == 1) PG8_BAR;
        PG8_WAIT_V(2); PG8_BAR;
        PG8_STAGE(PG8_SB(1, 0), cB + kstep, voffB); PG8_STAGE(PG8_SA(1, 0), cA + kstep, voffA); PG8_STAGE(PG8_SB(1, 1), cB + hstep + kstep, voffB);
        PG8_WAIT_V(6); PG8_BAR;
    } else {
        PG8_STAGE(PG8_SB(0, 0), cB, voffB); PG8_STAGE(PG8_SA(0, 0), cA, voffA); PG8_STAGE(PG8_SB(0, 1), cB + hstep, voffB); PG8_STAGE(PG8_SA(0, 1), cA + hstep, voffA);
        if (wr == 1) PG8_BAR;
        PG8_WAIT_V(4); PG8_BAR;
        PG8_STAGE(PG8_SB(1, 0), cB + kstep, voffB); PG8_STAGE(PG8_SA(1, 0), cA + kstep, voffA); PG8_STAGE(PG8_SB(1, 1), cB + hstep + kstep, voffB);
        PG8_WAIT_V(6); PG8_BAR;
    }
    for (;;) {
        const bool has_next = S.next(ui + 1, nxt);
        const char* nA = has_next ? (const char*)g.A + (size_t)nxt.pm * tstep : cA; const char* nB = has_next ? (const char*)g.Bt + (size_t)nxt.pn * tstep : cB;
        for (int t = 0; t < nt; t += 2) {
            const bool last = (t == nt - 2);
            const char* a1 = cA + (size_t)(t + 1) * kstep;
            const char* a2 = last ? nA : cA + (size_t)(t + 2) * kstep; const char* b2 = last ? nB : cB + (size_t)(t + 2) * kstep;
            const char* a3 = a2 + kstep; const char* b3 = b2 + kstep;
            if (last && has_next) S.a_ready(nxt);
            if constexpr (SP2) {
            PG8_LDB(B0, 0, 0); PG8_LDB(B1, 0, 1); PG8_SCHED; PG8_LDA(At, 0, 0); PG8_STAGE(PG8_SA(1, 1), a1 + hstep, voffA);
            PG8_WAIT_V(8); PG8_WAIT_L(0); PG8_BAR; PG8_MMA(0, 0, At, B0); PG8_MMA(0, 1, At, B1); PG8_BAR; PG8_SCHED;
            PG8_LDA(At, 0, 1); PG8_STAGE(PG8_SB(0, 0), b2, voffB); PG8_STAGE(PG8_SB(0, 1), b2 + hstep, voffB); PG8_STAGE(PG8_SA(0, 0), a2, voffA);
            PG8_WAIT_V(8); PG8_WAIT_L(0); PG8_BAR; PG8_MMA(1, 0, At, B0); PG8_MMA(1, 1, At, B1); PG8_BAR; PG8_SCHED;
            PG8_LDB(B0, 1, 0); PG8_LDB(B1, 1, 1); PG8_SCHED; PG8_LDA(At, 1, 0); PG8_STAGE(PG8_SA(0, 1), a2 + hstep, voffA);
            PG8_WAIT_V(8); PG8_WAIT_L(0); PG8_BAR; PG8_MMA(0, 0, At, B0); PG8_MMA(0, 1, At, B1); PG8_BAR; PG8_SCHED;
            PG8_LDA(At, 1, 1); PG8_STAGE(PG8_SB(1, 0), b3, voffB); PG8_STAGE(PG8_SB(1, 1), b3 + hstep, voffB); PG8_STAGE(PG8_SA(1, 0), a3, voffA);
            PG8_WAIT_V(8); PG8_WAIT_L(0); PG8_BAR; PG8_MMA(1, 0, At, B0); PG8_MMA(1, 1, At, B1); PG8_BAR; PG8_SCHED;
            } else {
            PG8_LDB(B0, 0, 0); PG8_SCHED; PG8_LDA(At, 0, 0); PG8_STAGE(PG8_SA(1, 1), a1 + hstep, voffA);
            PG8_WAIT_L(8); PG8_BAR; PG8_WAIT_L(0); PG8_MMA(0, 0, At, B0); PG8_BAR; PG8_SCHED;
            PG8_LDB(B1, 0, 1); PG8_STAGE(PG8_SB(0, 0), b2, voffB);
            PG8_BAR; PG8_WAIT_L(0); PG8_MMA(0, 1, At, B1); PG8_BAR;
            PG8_LDA(At, 0, 1); PG8_STAGE(PG8_SA(0, 0), a2, voffA);
            PG8_BAR; PG8_WAIT_L(0); PG8_MMA(1, 0, At, B0); PG8_BAR; PG8_SCHED;
            PG8_STAGE(PG8_SB(0, 1), b2 + hstep, voffB);
            PG8_WAIT_V(6); PG8_BAR; PG8_MMA(1, 1, At, B1); PG8_BAR;
            PG8_LDB(B0, 1, 0); PG8_SCHED; PG8_LDA(At, 1, 0); PG8_STAGE(PG8_SA(0, 1), a2 + hstep, voffA);
            PG8_WAIT_L(8); PG8_BAR; PG8_WAIT_L(0); PG8_MMA(0, 0, At, B0); PG8_BAR; PG8_SCHED;
            PG8_LDB(B1, 1, 1); PG8_STAGE(PG8_SB(1, 0), b3, voffB);
            PG8_BAR; PG8_WAIT_L(0); PG8_MMA(0, 1, At, B1); PG8_BAR;
            PG8_LDA(At, 1, 1); PG8_STAGE(PG8_SA(1, 0), a3, voffA);
            PG8_BAR; PG8_WAIT_L(0); PG8_MMA(1, 0, At, B0); PG8_BAR; PG8_SCHED;
            PG8_STAGE(PG8_SB(1, 1), b3 + hstep, voffB);
            PG8_WAIT_V(6); PG8_BAR; PG8_MMA(1, 1, At, B1); PG8_BAR;
            }
        }
        if constexpr (ALIGN_EPI) { if (wr == 0) PG8_BAR; }
        if constexpr (!Epi::AFTER_DRAIN) { E(acc, cur, wr, wc, fr, fq); S.done(cur); }
        if (!has_next) break;
#pragma unroll
        for (int a = 0; a < 2; ++a)
#pragma unroll
            for (int b = 0; b < 2; ++b)
#pragma unroll
                for (int m = 0; m < 4; ++m)
#pragma unroll
                    for (int n = 0; n < 2; ++n) acc[a][b][m][n] = (f32x4){0.f, 0.f, 0.f, 0.f};
        cur = nxt; cA = nA; cB = nB; ++ui;
        if constexpr (ALIGN_EPI) { if (wr == 1) PG8_BAR; }
    }
    PG8_WAIT_V(0);
    if constexpr (!ALIGN_EPI) { if (wr == 0) PG8_BAR; }
    PG8_BAR;
    if constexpr (Epi::AFTER_DRAIN) { E.fused(acc, cur, wr, wc, fr, fq, lds, wid, lane); S.done(cur); }
#undef PG8_SA
#undef PG8_SB
#undef PG8_STAGE
#undef PG8_LDA
#undef PG8_LDB
#undef PG8_MMA
#undef PG8_WAIT_V
#undef PG8_WAIT_L
#undef PG8_BAR
#undef PG8_SCHED
}
}
#ifndef PG8_SP2
#define PG8_SP2 true
#endif
#ifndef PG8_ALIGN
#define PG8_ALIGN true
#endif
#define LAS __attribute__((address_space(3)))
typedef unsigned short bf16;
typedef short bf16x8 __attribute__((ext_vector_type(8)));
typedef float f32x4 __attribute__((ext_vector_type(4)));
typedef float f32x16 __attribute__((ext_vector_type(16)));
typedef unsigned u32x4 __attribute__((ext_vector_type(4)));
typedef unsigned u32x2 __attribute__((ext_vector_type(2)));
constexpr int NB = 8, SEQ = 4096, DM = 1024, T = NB * SEQ, FF = 4096, MEMN = 256, MROWS = NB * MEMN;
constexpr int NA = 1536, NQ = 2048, NINB = 2056;
constexpr float EPS = 1e-6f, LOG2E = 1.4426950408889634f;
constexpr int NWAVES = 8;
constexpr int LDS_BYTES = 147456;
constexpr size_t MiB = 1u << 20;
constexpr size_t WS_WA = 1 * MiB, WS_WB = 4 * MiB, WS_WF = 8 * MiB, WS_WO = 9 * MiB, WS_W1 = 13 * MiB, WS_W2 = 29 * MiB, WS_WKV = 45 * MiB, WS_WR = 49 * MiB, WS_WI = 49 * MiB + 512 * 1024;
constexpr size_t WS_MEMB = 50 * MiB, WS_MEMSS = 54 * MiB, WS_KVRAW = 55 * MiB, WS_KN = 63 * MiB, WS_VT = 67 * MiB, WS_SSP = 71 * MiB, WS_AP = 73 * MiB, WS_HE = 74 * MiB, WS_CL = 75 * MiB, WS_CTOT = 76 * MiB;
constexpr size_t WS_XB = 80 * MiB, WS_H = 144 * MiB, WS_PROJ = 144 * MiB, WS_CAT = 272 * MiB, WS_QN = 336 * MiB, WS_KNF = 368 * MiB, WS_VTF = 400 * MiB, WS_END = 432 * MiB;

struct Ctx { const float* x; float* out; unsigned char* ws; int vcu, G; };
struct Args { const float* in[23]; float* out; unsigned char* ws; int ph_lo, ph_hi; };
constexpr size_t WS_PAR = 77 * MiB;
constexpr int PQG = 0, PKG = 256, PCW = 512, PCB = 2560, PBR = 3072, PBI = 3584, PLAM = 4096, PBF = 4608, PFQG = 4624, PFKG = 4688, PAR_N = 4752;
#define PHASE_IDS() int tid = threadIdx.x; asm volatile("" : "+v"(tid)); const int lane = tid & 63; const int wid = __builtin_amdgcn_readfirstlane(tid >> 6); unsigned char* ws = C.ws; asm volatile("" : "+s"(ws)); const float* par = (const float*)(ws + WS_PAR)
__device__ __forceinline__ float bf2f(unsigned short b) { return __uint_as_float((unsigned)b << 16); }
typedef __bf16 bf16x2_t __attribute__((ext_vector_type(2))); typedef float f32x2_t __attribute__((ext_vector_type(2)));
__device__ __forceinline__ unsigned pk2(float lo, float hi) { f32x2_t v = {lo, hi}; bf16x2_t b = __builtin_convertvector(v, bf16x2_t); return __builtin_bit_cast(unsigned, b); }
__device__ __forceinline__ unsigned short f2bf(float f) { return (unsigned short)(pk2(f, 0.f) & 0xffffu); }
__device__ __forceinline__ float wave_sum(float v) {
#pragma unroll
    for (int o = 1; o < 64; o <<= 1) v += __shfl_xor(v, o);
    return v;
}
__device__ __forceinline__ float wave_max(float v) {
#pragma unroll
    for (int o = 1; o < 64; o <<= 1) v = fmaxf(v, __shfl_xor(v, o));
    return v;
}
__device__ __forceinline__ int crow(int r, int hi) { return (r & 3) + 8 * (r >> 2) + 4 * hi; }
__device__ __forceinline__ int kperm(int p) { return 8 * ((p & 7) >> 2) + 4 * (p >> 3) + (p & 3); }
__device__ __forceinline__ float sigmoid_f(float x) { return __builtin_amdgcn_rcpf(1.0f + __builtin_amdgcn_exp2f(-LOG2E * x)); }

__device__ __forceinline__ void tr_item(const float* W, int ldw, int col0, bf16* WT, int K, int row0, const float* gain, int kb, int nb, LAS float* scr, int lane) {
    const int k0 = 64 * kb, n0 = 32 * nb;
#pragma unroll 8
    for (int i = 0; i < 32; ++i) { const int kk = 2 * i + (lane >> 5); const float g = gain ? gain[k0 + kk] : 1.0f;
        scr[kk * 33 + (lane & 31)] = W[(size_t)(k0 + kk) * ldw + col0 + n0 + (lane & 31)] * g; }
    asm volatile("s_waitcnt lgkmcnt(0)" ::: "memory");
    const int c = lane & 7;
#pragma unroll
    for (int j = 0; j < 4; ++j) { const int n = (lane >> 3) + 8 * j; const LAS float* s = scr + (8 * c) * 33 + n;
        u32x4 o; o.x = pk2(s[0 * 33], s[1 * 33]); o.y = pk2(s[2 * 33], s[3 * 33]); o.z = pk2(s[4 * 33], s[5 * 33]); o.w = pk2(s[6 * 33], s[7 * 33]);
        *(u32x4*)(WT + (size_t)(row0 + n0 + n) * K + k0 + 8 * c) = o; }
    asm volatile("s_waitcnt lgkmcnt(0)" ::: "memory");
}
__device__ __forceinline__ void row_to_bf16(const float* xrow, bf16* orow, float* ssrow, int lane) {
    const f32x4* xr = (const f32x4*)xrow + lane; f32x4 v[4]; float s = 0.f;
#pragma unroll
    for (int j = 0; j < 4; ++j) { v[j] = xr[64 * j]; s += (v[j][0] * v[j][0] + v[j][1] * v[j][1]) + (v[j][2] * v[j][2] + v[j][3] * v[j][3]); }
    s = wave_sum(s);
    u32x2* o = (u32x2*)orow + lane;
#pragma unroll
    for (int j = 0; j < 4; ++j) { u32x2 w; w.x = pk2(v[j][0], v[j][1]); w.y = pk2(v[j][2], v[j][3]); o[64 * j] = w; }
    if (lane < 16) ssrow[lane] = (lane == 0) ? s : 0.f;
}
__device__ __forceinline__ void p0_prologue(const Args& A, const Ctx& C, LAS unsigned char* lds) {
    PHASE_IDS();
    LAS float* scr = (LAS float*)(lds + wid * 16384);
    const int gw = C.vcu * NWAVES + wid, NGW = C.G * NWAVES;
    if (C.vcu == 0) { float* pw = (float*)(ws + WS_PAR);
        for (int e = tid; e < PAR_N; e += 512) { float v = 0.f;
            if (e < PKG) v = A.in[5][e - PQG]; else if (e < PCW) v = A.in[6][e - PKG]; else if (e < PCB) v = A.in[12][e - PCW]; else if (e < PBR) v = A.in[13][e - PCB];
            else if (e < PBI) v = A.in[15][e - PBR]; else if (e < PLAM) v = A.in[17][e - PBI]; else if (e < PBF) v = A.in[18][e - PLAM]; else if (e < PBF + 8) v = A.in[20][e - PBF];
            else if (e < PFQG) v = 0.f; else if (e < PFKG) v = A.in[21][e - PFQG]; else v = A.in[22][e - PFKG];
            pw[e] = v; } }
    constexpr int I0 = 16 * 48, I1 = 16 * 48, I2 = 16 * 16, I3 = 16 * 32, I5 = 16 * 128, I7 = 64 * 32, I9 = 16 * 32, I11 = 16;
    constexpr int NITEMS = I0 + I1 + I2 + 2 * I3 + 2 * I5 + 2 * I7 + 2 * I9 + 2 * I11;
    for (int it = gw; it < NITEMS; it += NGW) {
        int r = it;
        if (r < I0) { tr_item(A.in[11], NA, 0, (bf16*)(ws + WS_WA), DM, 0, A.in[2], r / 48, r % 48, scr, lane); continue; } r -= I0;
        if (r < I1) { tr_item(A.in[19], NINB, 0, (bf16*)(ws + WS_WB), DM, 0, A.in[2] + DM, r / 48, r % 48, scr, lane); continue; } r -= I1;
        if (r < I2) { tr_item(A.in[19], NINB, 1544, (bf16*)(ws + WS_WB), DM, 1536, A.in[2] + DM, r / 16, r % 16, scr, lane); continue; } r -= I2;
        if (r < 2 * I3) { const int l = r / I3; r %= I3; tr_item(A.in[7] + (size_t)l * DM * DM, DM, 0, (bf16*)(ws + WS_WO) + (size_t)l * DM * DM, DM, 0, nullptr, r / 32, r % 32, scr, lane); continue; } r -= 2 * I3;
        if (r < 2 * I5) { const int l = r / I5; r %= I5; tr_item(A.in[9] + (size_t)l * DM * FF, FF, 0, (bf16*)(ws + WS_W1) + (size_t)l * DM * FF, DM, 0, A.in[8] + l * DM, r / 128, r % 128, scr, lane); continue; } r -= 2 * I5;
        if (r < 2 * I7) { const int l = r / I7; r %= I7; tr_item(A.in[10] + (size_t)l * DM * FF, DM, 0, (bf16*)(ws + WS_W2) + (size_t)l * DM * FF, FF, 0, nullptr, r / 32, r % 32, scr, lane); continue; } r -= 2 * I7;
        if (r < 2 * I9) { const int l = r / I9; r %= I9; tr_item(A.in[4] + (size_t)l * DM * DM, DM, 0, (bf16*)(ws + WS_WKV) + (size_t)l * DM * DM, DM, 0, A.in[3] + l * DM, r / 32, r % 32, scr, lane); continue; } r -= 2 * I9;
        if (r < I11) { tr_item(A.in[14] + (size_t)(r >> 1) * 4096, 64, 0, (bf16*)(ws + WS_WR) + (size_t)(r >> 1) * 4096, 64, 0, nullptr, 0, r & 1, scr, lane); continue; } r -= I11;
        tr_item(A.in[16] + (size_t)(r >> 1) * 4096, 64, 0, (bf16*)(ws + WS_WI) + (size_t)(r >> 1) * 4096, 64, 0, nullptr, 0, r & 1, scr, lane);
    }
    { bf16* wf = (bf16*)(ws + WS_WF); const float* wb = A.in[19]; const float* g = A.in[2] + DM;
      for (int e = (C.vcu * 512 + tid); e < 16 * DM; e += C.G * 512) { const int n = e >> 10, k = e & 1023; wf[e] = (n < 8) ? f2bf(wb[(size_t)k * NINB + 1536 + n] * g[k]) : (unsigned short)0; } }
    for (int m = gw; m < T; m += NGW) row_to_bf16(A.in[0] + (size_t)m * DM, (bf16*)(ws + WS_XB) + (size_t)m * DM, (float*)(ws + WS_SSP) + (size_t)m * 16, lane);
    for (int m = gw; m < MROWS; m += NGW) row_to_bf16(A.in[1] + (size_t)m * DM, (bf16*)(ws + WS_MEMB) + (size_t)m * DM, (float*)(ws + WS_MEMSS) + (size_t)m * 16, lane);
}

template <bool FINAL> __device__ __forceinline__ void lru_unit(const Ctx& C, LAS unsigned char* lds, int b, int ck) {
    PHASE_IDS();
    LAS bf16* UC = (LAS bf16*)lds;
    LAS float* Aa = (LAS float*)(lds + 16640);
    LAS float* Bb = (LAS float*)(lds + 16640 + 32768);
    const bf16* WRt = (const bf16*)(ws + WS_WR) + wid * 4096; const bf16* WIt = (const bf16*)(ws + WS_WI) + wid * 4096;
    bf16x8 br[4][2], bi[4][2];
#pragma unroll
    for (int j = 0; j < 4; ++j)
#pragma unroll
        for (int kk = 0; kk < 2; ++kk) { const int o = (16 * j + (lane & 15)) * 64 + 32 * kk + 8 * (lane >> 4); br[j][kk] = *(const bf16x8*)(WRt + o); bi[j][kk] = *(const bf16x8*)(WIt + o); }
    float cbr[4], cbi[4], csp[4];
#pragma unroll
    for (int j = 0; j < 4; ++j) { const int d = wid * 64 + 16 * j + (lane & 15); cbr[j] = par[PBR + d]; cbi[j] = par[PBI + d];
        const float lam = par[PLAM + d]; const float sp = (lam < -20.f) ? -lam : log1pf(expf(-lam)); csp[j] = 8.0f * sp * LOG2E; }
    const int ch = tid;
    const float cw0 = par[PCW + ch], cw1 = par[PCW + 512 + ch], cw2 = par[PCW + 1024 + ch], cw3 = par[PCW + 1536 + ch], cb = par[PCB + ch];
    const size_t t0 = (size_t)b * SEQ + (size_t)ck * 128;
    const bf16* proj = (const bf16*)(ws + WS_PROJ);
    const bf16* up = proj + t0 * NA + ch;
    float um3 = 0.f, um2 = 0.f, um1 = 0.f;
    if (ck > 0) { um3 = bf2f(*(up - 3 * NA)); um2 = bf2f(*(up - 2 * NA)); um1 = bf2f(*(up - NA)); }
    float h = 0.f, P = 1.f;
    if (FINAL) { const float* ap = (const float*)(ws + WS_AP) + (size_t)b * 32 * 512 + ch; const float* he = (const float*)(ws + WS_HE) + (size_t)b * 32 * 512 + ch;
        for (int k = 0; k < ck; ++k) h = ap[k * 512] * h + he[k * 512]; }
    bf16* cat = (bf16*)(ws + WS_CAT);
    for (int st = 0; st < 8; ++st) {
        float uc[16];
#pragma unroll
        for (int tt = 0; tt < 16; ++tt) { const float u0 = bf2f(up[(size_t)(st * 16 + tt) * NA]); uc[tt] = cw0 * um3 + cw1 * um2 + cw2 * um1 + cw3 * u0 + cb; um3 = um2; um2 = um1; um1 = u0; UC[tt * 520 + ch] = f2bf(uc[tt]); }
        __syncthreads();
        { const bf16x8 a0 = *(const LAS bf16x8*)(UC + (lane & 15) * 520 + wid * 64 + 8 * (lane >> 4)), a1 = *(const LAS bf16x8*)(UC + (lane & 15) * 520 + wid * 64 + 32 + 8 * (lane >> 4));
#pragma unroll
          for (int j = 0; j < 4; ++j) {
            f32x4 r = {0.f, 0.f, 0.f, 0.f}, g = {0.f, 0.f, 0.f, 0.f};
            r = __builtin_amdgcn_mfma_f32_16x16x32_bf16(a0, br[j][0], r, 0, 0, 0); r = __builtin_amdgcn_mfma_f32_16x16x32_bf16(a1, br[j][1], r, 0, 0, 0);
            g = __builtin_amdgcn_mfma_f32_16x16x32_bf16(a0, bi[j][0], g, 0, 0, 0); g = __builtin_amdgcn_mfma_f32_16x16x32_bf16(a1, bi[j][1], g, 0, 0, 0);
#pragma unroll
            for (int i = 0; i < 4; ++i) { const int tok = (lane >> 4) * 4 + i; const float rr = sigmoid_f(r[i] + cbr[j]), ii = sigmoid_f(g[i] + cbi[j]);
                const float a = __builtin_amdgcn_exp2f(-rr * csp[j]); const float bb = sqrtf(fmaxf(1.0f - a * a, 0.f)) * ii;
                const int o = tok * 512 + wid * 64 + 16 * j + (lane & 15); Aa[o] = a; Bb[o] = bb; }
          } }
        __syncthreads();
#pragma unroll
        for (int tt = 0; tt < 16; ++tt) { const float a = Aa[tt * 512 + ch], bb = Bb[tt * 512 + ch]; h = a * h + bb * uc[tt];
            if (FINAL) { const size_t t = t0 + st * 16 + tt; const float gt = bf2f(proj[t * NA + 512 + ch]); cat[t * DM + ch] = f2bf(h * gt); } else { P *= a; } }
    }
    if (!FINAL) { ((float*)(ws + WS_AP))[((size_t)b * 32 + ck) * 512 + ch] = P; ((float*)(ws + WS_HE))[((size_t)b * 32 + ck) * 512 + ch] = h; }
    __syncthreads();
}

__device__ __forceinline__ void memkv_item(const Ctx& C, int item) {
    PHASE_IDS();
    const int l = item >> 7, b = (item >> 4) & 7, h = (item >> 2) & 3, mg = item & 3;
    const bf16* kvraw = (const bf16*)(ws + WS_KVRAW);
    const float* kg = par + PKG + l * 128;
    const float c2m = LOG2E * 0.08838834764831845f;
    const float g0 = kg[2 * lane] * c2m, g1 = kg[2 * lane + 1] * c2m;
    const size_t hb = (((size_t)l * 8 + b) * 4 + h);
    bf16* kn = (bf16*)(ws + WS_KN) + hb * 256 * 128;
#pragma unroll
    for (int rr = 0; rr < 8; ++rr) { const int m = mg * 64 + wid * 8 + rr;
        const unsigned kv2 = *(const unsigned*)(kvraw + (size_t)(b * 256 + m) * 2048 + l * 1024 + h * 128 + 2 * lane);
        const float k0 = __uint_as_float(kv2 << 16), k1 = __uint_as_float(kv2 & 0xffff0000u);
        const float ss = wave_sum(k0 * k0 + k1 * k1); const float rinv = 1.0f / sqrtf(ss * (1.0f / 128.0f) + EPS);
        *(unsigned*)(kn + (size_t)m * 128 + 2 * lane) = pk2(k0 * rinv * g0, k1 * rinv * g1); }
    { const int d = tid & 127, mq = tid >> 7; unsigned w[8];
      const bf16* vp = kvraw + (size_t)(b * 256 + mg * 64 + mq * 16) * 2048 + l * 1024 + 512 + h * 128 + d;
#pragma unroll
      for (int p = 0; p < 16; p += 2) { const unsigned lo = vp[(size_t)kperm(p) * 2048], hi = vp[(size_t)kperm(p + 1) * 2048]; w[p >> 1] = lo | (hi << 16); }
      bf16* vt = (bf16*)(ws + WS_VT) + (hb * 128 + d) * 256 + mg * 64 + mq * 16;
      *(u32x4*)vt = (u32x4){w[0], w[1], w[2], w[3]}; *(u32x4*)(vt + 8) = (u32x4){w[4], w[5], w[6], w[7]}; }
}

__device__ __forceinline__ void memattn_unit(const Ctx& C, LAS unsigned char* lds, int l, int unit, const bf16* xq, int ldq) {
    PHASE_IDS();
    const int b = unit >> 5, h = (unit >> 3) & 3, tg = unit & 7, r32 = lane & 31, hi = lane >> 5;
    LAS bf16* Ks = (LAS bf16*)lds;
    LAS bf16* Vs = (LAS bf16*)(lds + 69632);
    LAS float* wsf = (LAS float*)(lds + 137216) + wid * 32;
    const size_t hb = (((size_t)l * 8 + b) * 4 + h);
    const bf16* kn = (const bf16*)(ws + WS_KN) + hb * 256 * 128; const bf16* vt = (const bf16*)(ws + WS_VT) + hb * 128 * 256;
#pragma unroll
    for (int i = 0; i < 8; ++i) { const int idx = tid + 512 * i; const int row = idx >> 4, c = idx & 15; *(LAS u32x4*)(Ks + row * 136 + c * 8) = *(const u32x4*)(kn + row * 128 + c * 8); }
#pragma unroll
    for (int i = 0; i < 8; ++i) { const int idx = tid + 512 * i; const int row = idx >> 5, c = idx & 31; *(LAS u32x4*)(Vs + row * 264 + c * 8) = *(const u32x4*)(vt + row * 256 + c * 8); }
    const float* qg = par + PQG + l * 128; const float* kg = par + PKG + l * 128;
    const float gq = wave_max(fmaxf(fabsf(qg[2 * lane]), fabsf(qg[2 * lane + 1]))), gk = wave_max(fmaxf(fabsf(kg[2 * lane]), fabsf(kg[2 * lane + 1])));
    const float bound = gq * gk * 11.313708498984761f * LOG2E;
    __syncthreads();
    bf16* cat = (bf16*)(ws + WS_CAT);
#pragma unroll 1
    for (int sub = 0; sub < 2; ++sub) {
        const size_t tok0 = (size_t)b * SEQ + tg * 512 + sub * 256 + wid * 32;
        bf16x8 qf[8];
        { const bf16* qp = xq + (tok0 + r32) * ldq + h * 128 + 8 * hi; float ss = 0.f;
#pragma unroll
          for (int ds = 0; ds < 8; ++ds) { qf[ds] = *(const bf16x8*)(qp + 16 * ds);
#pragma unroll
              for (int j = 0; j < 8; ++j) { const float f = bf2f((unsigned short)qf[ds][j]); ss += f * f; } }
          ss += __shfl_xor(ss, 32); const float rinv = 1.0f / sqrtf(ss * (1.0f / 128.0f) + EPS);
#pragma unroll
          for (int ds = 0; ds < 8; ++ds) { const f32x4 ga = *(const f32x4*)(qg + 16 * ds + 8 * hi), gb = *(const f32x4*)(qg + 16 * ds + 8 * hi + 4);
              unsigned w[4];
#pragma unroll
              for (int j = 0; j < 4; ++j) { const float f0 = bf2f((unsigned short)qf[ds][2 * j]) * rinv * (2 * j < 4 ? ga[(2 * j) & 3] : gb[(2 * j) & 3]);
                  const float f1 = bf2f((unsigned short)qf[ds][2 * j + 1]) * rinv * (2 * j + 1 < 4 ? ga[(2 * j + 1) & 3] : gb[(2 * j + 1) & 3]); w[j] = pk2(f0, f1); }
              qf[ds] = __builtin_bit_cast(bf16x8, (u32x4){w[0], w[1], w[2], w[3]}); } }
        f32x16 o[4]; float lsum = 0.f;
#pragma unroll
        for (int db = 0; db < 4; ++db)
#pragma unroll
            for (int r = 0; r < 16; ++r) o[db][r] = 0.f;
#pragma unroll 1
        for (int kb = 0; kb < 8; ++kb) {
            f32x16 p0;
#pragma unroll
            for (int r = 0; r < 16; ++r) p0[r] = -bound;
#pragma unroll
            for (int ds = 0; ds < 8; ++ds) { const bf16x8 k0 = *(const LAS bf16x8*)(Ks + (32 * kb + r32) * 136 + 16 * ds + 8 * hi);
                p0 = __builtin_amdgcn_mfma_f32_32x32x16_bf16(k0, qf[ds], p0, 0, 0, 0); if ((ds & 3) == 3) __builtin_amdgcn_sched_barrier(0); }
#pragma unroll
            for (int r = 0; r < 16; ++r) { p0[r] = __builtin_amdgcn_exp2f(p0[r]); lsum += p0[r]; }
            bf16x8 pa[2];
            pa[0] = __builtin_bit_cast(bf16x8, (u32x4){pk2(p0[0], p0[1]), pk2(p0[2], p0[3]), pk2(p0[4], p0[5]), pk2(p0[6], p0[7])});
            pa[1] = __builtin_bit_cast(bf16x8, (u32x4){pk2(p0[8], p0[9]), pk2(p0[10], p0[11]), pk2(p0[12], p0[13]), pk2(p0[14], p0[15])});
#pragma unroll
            for (int db = 0; db < 4; ++db) {
#pragma unroll
                for (int s = 0; s < 2; ++s) { const bf16x8 v = *(const LAS bf16x8*)(Vs + (32 * db + r32) * 264 + 32 * kb + 16 * s + 8 * hi);
                    o[db] = __builtin_amdgcn_mfma_f32_32x32x16_bf16(pa[s], v, o[db], 0, 0, 0); }
                if (db & 1) __builtin_amdgcn_sched_barrier(0); }
        }
        lsum += __shfl_xor(lsum, 32);
        if (hi == 0) wsf[r32] = lsum;
        asm volatile("s_waitcnt lgkmcnt(0)" ::: "memory");
#pragma unroll
        for (int r = 0; r < 16; ++r) { const float rl = __builtin_amdgcn_rcpf(wsf[crow(r, hi)]); bf16* op = cat + (tok0 + crow(r, hi)) * DM + 512 + h * 128 + r32;
#pragma unroll
            for (int db = 0; db < 4; ++db) op[32 * db] = f2bf(o[db][r] * rl); }
        asm volatile("s_waitcnt lgkmcnt(0)" ::: "memory");
    }
    __syncthreads();
}

__device__ __forceinline__ void foxprep_unit(const Ctx& C, LAS unsigned char* lds, int unit) {
    PHASE_IDS();
    const int b = unit >> 6, ck = unit & 63;
    LAS float* LF = (LAS float*)lds;
    const size_t t0 = (size_t)b * SEQ + (size_t)ck * 64;
    const bf16* proj = (const bf16*)(ws + WS_PROJ);
    if (wid < 4) {
        f32x4 acc = {0.f, 0.f, 0.f, 0.f};
        const bf16* ap = (const bf16*)(ws + WS_XB) + (t0 + 16 * wid + (lane & 15)) * DM + 8 * (lane >> 4);
        const bf16* bp = (const bf16*)(ws + WS_WF) + (size_t)(lane & 15) * DM + 8 * (lane >> 4);
#pragma unroll 4
        for (int ks = 0; ks < 32; ++ks) acc = __builtin_amdgcn_mfma_f32_16x16x32_bf16(*(const bf16x8*)(ap + 32 * ks), *(const bf16x8*)(bp + 32 * ks), acc, 0, 0, 0);
        const int n = lane & 15; const float bfg = par[PBF + n];
#pragma unroll
        for (int i = 0; i < 4; ++i) { const int row = 16 * wid + (lane >> 4) * 4 + i;
            const f32x4* sp = (const f32x4*)((const float*)(ws + WS_SSP) + (t0 + row) * 16); const f32x4 s0 = sp[0], s1 = sp[1], s2 = sp[2], s3 = sp[3];
            const float ss = ((s0[0] + s0[1]) + (s0[2] + s0[3])) + ((s1[0] + s1[1]) + (s1[2] + s1[3])) + ((s2[0] + s2[1]) + (s2[2] + s2[3])) + ((s3[0] + s3[1]) + (s3[2] + s3[3]));
            const float rs = 1.0f / sqrtf(ss * (1.0f / 1024.0f) + EPS);
            const float logit = acc[i] * rs + bfg;
            const float lf = -__builtin_amdgcn_logf(1.0f + __builtin_amdgcn_exp2f(-LOG2E * logit));
            if (n < 8) LF[row * 8 + n] = lf; }
    }
    { const float c2f = 0.125f * LOG2E;
      for (int jb = wid; jb < 128; jb += 8) { const int which = jb >> 6; const size_t tok = t0 + (jb & 63);
        const bf16x8 v = *(const bf16x8*)(proj + tok * NQ + which * 512 + 8 * lane); float f[8]; float ss = 0.f;
#pragma unroll
        for (int j = 0; j < 8; ++j) { f[j] = bf2f((unsigned short)v[j]); ss += f[j] * f[j]; }
        ss += __shfl_xor(ss, 1); ss += __shfl_xor(ss, 2); ss += __shfl_xor(ss, 4);
        const float rinv = (1.0f / sqrtf(ss * (1.0f / 64.0f) + EPS)) * (which ? 1.0f : c2f);
        const float* gp = par + (which ? PFKG : PFQG) + ((8 * lane) & 63); const f32x4 ga = *(const f32x4*)gp, gb = *(const f32x4*)(gp + 4);
        u32x4 w; w.x = pk2(f[0] * rinv * ga[0], f[1] * rinv * ga[1]); w.y = pk2(f[2] * rinv * ga[2], f[3] * rinv * ga[3]); w.z = pk2(f[4] * rinv * gb[0], f[5] * rinv * gb[1]); w.w = pk2(f[6] * rinv * gb[2], f[7] * rinv * gb[3]);
        *(u32x4*)((bf16*)(ws + (which ? WS_KNF : WS_QN)) + tok * 512 + 8 * lane) = w; } }
    { const int hd = tid; bf16* vtf = (bf16*)(ws + WS_VTF) + (((size_t)b * 8 + (hd >> 6)) * 64 + (hd & 63)) * SEQ + (size_t)ck * 64;
      for (int g = 0; g < 4; ++g) { unsigned w[8]; const bf16* vp = proj + (t0 + 16 * g) * NQ + 1024 + hd;
#pragma unroll
        for (int p = 0; p < 16; p += 2) { const unsigned lo = vp[(size_t)kperm(p) * NQ], hi = vp[(size_t)kperm(p + 1) * NQ]; w[p >> 1] = lo | (hi << 16); }
        *(u32x4*)(vtf + 16 * g) = (u32x4){w[0], w[1], w[2], w[3]}; *(u32x4*)(vtf + 16 * g + 8) = (u32x4){w[4], w[5], w[6], w[7]}; } }
    __syncthreads();
    if (tid < 8) { float c = 0.f; float* cl = (float*)(ws + WS_CL) + ((size_t)b * 8 + tid) * SEQ + (size_t)ck * 64;
        for (int row = 0; row < 64; ++row) { c += LF[row * 8 + tid]; cl[row] = c; }
        ((float*)(ws + WS_CTOT))[((size_t)b * 8 + tid) * 64 + ck] = c; }
    __syncthreads();
}

__device__ __forceinline__ void fox_unit(const Ctx& C, LAS unsigned char* lds, int b, int h, int qb) {
    PHASE_IDS();
    const int r32 = lane & 31, hi = lane >> 5;
    LAS bf16* Ks = (LAS bf16*)lds;
    LAS bf16* Vs = (LAS bf16*)(lds + 9216);
    LAS float* CJ = (LAS float*)(lds + 18432);
    LAS float* COF = (LAS float*)(lds + 18688);
    LAS float* wsf = (LAS float*)(lds + 18944) + wid * 32;
    const size_t bh = (size_t)b * 8 + h;
    const float* cl = (const float*)(ws + WS_CL) + bh * SEQ;
    if (wid == 0) { const float own = ((const float*)(ws + WS_CTOT))[bh * 64 + lane]; float v = own;
#pragma unroll
        for (int o = 1; o < 64; o <<= 1) { const float t = __shfl_up(v, o); if (lane >= o) v += t; }
        COF[lane] = v - own; }
    const float* qg = par + PFQG; const float* kg = par + PFKG;
    const float gq = wave_max(fabsf(qg[lane])), gk = wave_max(fabsf(kg[lane]));
    const float bound = 8.0f * gq * gk * LOG2E;
    __syncthreads();
    const float base = COF[4 * qb];
    const int q0 = 256 * qb, qw0 = q0 + 32 * wid, qrow = qw0 + r32;
    const float ci = cl[qrow] + (COF[qrow >> 6] - base) - bound;
    bf16x8 qf[4];
    { const bf16* qp = (const bf16*)(ws + WS_QN) + ((size_t)b * SEQ + qrow) * 512 + h * 64 + 8 * hi;
#pragma unroll
      for (int ds = 0; ds < 4; ++ds) qf[ds] = *(const bf16x8*)(qp + 16 * ds); }
    const int NT = 4 * (qb + 1);
    const bf16* kp = (const bf16*)(ws + WS_KNF) + ((size_t)b * SEQ + (tid >> 3)) * 512 + h * 64 + (tid & 7) * 8;
    const bf16* vp = (const bf16*)(ws + WS_VTF) + (bh * 64 + (tid >> 3)) * SEQ + (tid & 7) * 8;
    u32x4 kreg = *(const u32x4*)kp, vreg = *(const u32x4*)vp; float cjreg = (tid < 64) ? cl[tid] : 0.f;
    f32x16 o[2]; float lsum = 0.f;
#pragma unroll
    for (int r = 0; r < 16; ++r) { o[0][r] = 0.f; o[1][r] = 0.f; }
    for (int j = 0; j < NT; ++j) {
        __syncthreads();
        *(LAS u32x4*)(Ks + (tid >> 3) * 72 + (tid & 7) * 8) = kreg; *(LAS u32x4*)(Vs + (tid >> 3) * 72 + (tid & 7) * 8) = vreg;
        if (tid < 64) CJ[tid] = cjreg + (COF[j] - base);
        __syncthreads();
        if (j + 1 < NT) { kreg = *(const u32x4*)(kp + (size_t)(j + 1) * 64 * 512); vreg = *(const u32x4*)(vp + (j + 1) * 64); if (tid < 64) cjreg = cl[(j + 1) * 64 + tid]; }
        if (64 * j <= qw0 + 31) {
            f32x16 p0, p1;
#pragma unroll
            for (int g = 0; g < 4; ++g) { const f32x4 c0 = *(const LAS f32x4*)(CJ + 8 * g + 4 * hi), c1 = *(const LAS f32x4*)(CJ + 32 + 8 * g + 4 * hi);
#pragma unroll
                for (int e = 0; e < 4; ++e) { p0[4 * g + e] = ci - c0[e]; p1[4 * g + e] = ci - c1[e]; } }
            if (64 * j + 63 > qw0) {
#pragma unroll
                for (int r = 0; r < 16; ++r) { const int kv = 64 * j + crow(r, hi); if (kv > qrow) p0[r] = -INFINITY; if (kv + 32 > qrow) p1[r] = -INFINITY; } }
#pragma unroll
            for (int ds = 0; ds < 4; ++ds) { const bf16x8 k0 = *(const LAS bf16x8*)(Ks + r32 * 72 + 16 * ds + 8 * hi), k1 = *(const LAS bf16x8*)(Ks + (32 + r32) * 72 + 16 * ds + 8 * hi);
                p0 = __builtin_amdgcn_mfma_f32_32x32x16_bf16(k0, qf[ds], p0, 0, 0, 0); p1 = __builtin_amdgcn_mfma_f32_32x32x16_bf16(k1, qf[ds], p1, 0, 0, 0); }
#pragma unroll
            for (int r = 0; r < 16; ++r) { p0[r] = __builtin_amdgcn_exp2f(p0[r]); p1[r] = __builtin_amdgcn_exp2f(p1[r]); lsum += p0[r] + p1[r]; }
            bf16x8 pa[4];
            pa[0] = __builtin_bit_cast(bf16x8, (u32x4){pk2(p0[0], p0[1]), pk2(p0[2], p0[3]), pk2(p0[4], p0[5]), pk2(p0[6], p0[7])});
            pa[1] = __builtin_bit_cast(bf16x8, (u32x4){pk2(p0[8], p0[9]), pk2(p0[10], p0[11]), pk2(p0[12], p0[13]), pk2(p0[14], p0[15])});
            pa[2] = __builtin_bit_cast(bf16x8, (u32x4){pk2(p1[0], p1[1]), pk2(p1[2], p1[3]), pk2(p1[4], p1[5]), pk2(p1[6], p1[7])});
            pa[3] = __builtin_bit_cast(bf16x8, (u32x4){pk2(p1[8], p1[9]), pk2(p1[10], p1[11]), pk2(p1[12], p1[13]), pk2(p1[14], p1[15])});
#pragma unroll
            for (int db = 0; db < 2; ++db)
#pragma unroll
                for (int s = 0; s < 4; ++s) { const bf16x8 v = *(const LAS bf16x8*)(Vs + (32 * db + r32) * 72 + 16 * s + 8 * hi);
                    o[db] = __builtin_amdgcn_mfma_f32_32x32x16_bf16(pa[s], v, o[db], 0, 0, 0); }
        }
    }
    lsum += __shfl_xor(lsum, 32);
    if (hi == 0) wsf[r32] = lsum;
    asm volatile("s_waitcnt lgkmcnt(0)" ::: "memory");
    bf16* cat = (bf16*)(ws + WS_CAT);
#pragma unroll
    for (int r = 0; r < 16; ++r) { const float rl = __builtin_amdgcn_rcpf(wsf[crow(r, hi)]); bf16* op = cat + ((size_t)b * SEQ + qw0 + crow(r, hi)) * DM + h * 64 + r32;
        op[0] = f2bf(o[0][r] * rl); op[32] = f2bf(o[1][r] * rl); }
    __syncthreads();
}

constexpr int NPHASE = 13;
__global__ void __launch_bounds__(NWAVES * 64, 2) fwd_kernel(Args args) {
    extern __shared__ __attribute__((aligned(16))) unsigned char lds_raw[];
    LAS unsigned char* lds = (LAS unsigned char*)lds_raw;
    Ctx C;
    C.x = args.in[0]; C.out = args.out; C.ws = args.ws;
    C.G = gridDim.x; { const int bx = blockIdx.x; C.vcu = (C.G % 8 == 0) ? (bx % 8) * (C.G / 8) + bx / 8 : bx; }
    unsigned char* ws = args.ws;
    const int lo = args.ph_lo, hi = args.ph_hi;
#ifndef PHASE_MASK
#define PHASE_MASK 0x1fff
#endif
#define IN(k) (((PHASE_MASK >> (k)) & 1) && lo <= (k) && (k) < hi)
#define SEAM(k) do { if (IN(k) && IN((k) + 1)) { cg::this_grid().sync(); } } while (0)
    bf16* XB = (bf16*)(ws + WS_XB); float* SSP = (float*)(ws + WS_SSP); bf16* PROJ = (bf16*)(ws + WS_PROJ); bf16* CAT = (bf16*)(ws + WS_CAT); bf16* HB = (bf16*)(ws + WS_H);

    if (IN(0)) { p0_prologue(args, C, lds); } SEAM(0);
    if (IN(1)) {
        { pg8::Gemm g{(const bf16*)(ws + WS_MEMB), (const bf16*)(ws + WS_WKV), MROWS, 2048, DM}; pg8::StaticOrder S; S.init(MROWS, 2048, C.G, (int)blockIdx.x);
          pg8::EpiAct<0> E{(bf16*)(ws + WS_KVRAW), 2048, (const float*)(ws + WS_MEMSS), 1.0f / DM, EPS};
          pg8::gemm_phase<pg8::EpiAct<0>, pg8::StaticOrder, PG8_ALIGN, PG8_SP2>(lds, g, S, E); }
        { pg8::Gemm g{XB, (const bf16*)(ws + WS_WA), T, NA, DM}; pg8::StaticOrder S; S.init(T, NA, C.G, (int)blockIdx.x);
          pg8::EpiAct<1> E{PROJ, NA, SSP, 1.0f / DM, EPS};
          pg8::gemm_phase<pg8::EpiAct<1>, pg8::StaticOrder, PG8_ALIGN, PG8_SP2>(lds, g, S, E); }
    } SEAM(1);
    if (IN(2)) {
        for (int u = C.vcu; u < 256; u += C.G) memkv_item(C, u);
        for (int u = C.vcu; u < 256; u += C.G) lru_unit<false>(C, lds, u >> 5, u & 31);
    } SEAM(2);
    if (IN(3)) {
        for (int u = C.vcu; u < 256; u += C.G) lru_unit<true>(C, lds, u >> 5, u & 31);
        for (int u = C.vcu; u < 256; u += C.G) memattn_unit(C, lds, 0, u, PROJ + 1024, NA);
    } SEAM(3);
    if (IN(4)) { pg8::Gemm g{CAT, (const bf16*)(ws + WS_WO), T, DM, DM}; pg8::StaticOrder S; S.init(T, DM, C.G, (int)blockIdx.x);
        pg8::EpiRes E{C.x, C.out, XB, SSP, DM};
        pg8::gemm_phase<pg8::EpiRes, pg8::StaticOrder, PG8_ALIGN, PG8_SP2>(lds, g, S, E); } SEAM(4);
    if (IN(5)) { pg8::Gemm g{XB, (const bf16*)(ws + WS_W1), T, FF, DM}; pg8::StaticOrder S; S.init(T, FF, C.G, (int)blockIdx.x);
        pg8::EpiAct<2> E{HB, FF, SSP, 1.0f / DM, EPS};
        pg8::gemm_phase<pg8::EpiAct<2>, pg8::StaticOrder, PG8_ALIGN, PG8_SP2>(lds, g, S, E); } SEAM(5);
    if (IN(6)) { pg8::Gemm g{HB, (const bf16*)(ws + WS_W2), T, DM, FF}; pg8::StaticOrder S; S.init(T, DM, C.G, (int)blockIdx.x);
        pg8::EpiRes E{C.out, C.out, XB, SSP, DM};
        pg8::gemm_phase<pg8::EpiRes, pg8::StaticOrder, PG8_ALIGN, PG8_SP2>(lds, g, S, E); } SEAM(6);
    if (IN(7)) { pg8::Gemm g{XB, (const bf16*)(ws + WS_WB), T, NQ, DM}; pg8::StaticOrder S; S.init(T, NQ, C.G, (int)blockIdx.x);
        pg8::EpiAct<0> E{PROJ, NQ, SSP, 1.0f / DM, EPS};
        pg8::gemm_phase<pg8::EpiAct<0>, pg8::StaticOrder, PG8_ALIGN, PG8_SP2>(lds, g, S, E); } SEAM(7);
    if (IN(8)) {
        for (int u = C.vcu; u < 512; u += C.G) foxprep_unit(C, lds, u);
        for (int u = C.vcu; u < 256; u += C.G) memattn_unit(C, lds, 1, u, PROJ + 1536, NQ);
    } SEAM(8);
    if (IN(9)) {
        for (int u = C.vcu; u < 1024; u += C.G) { const int i = u / C.G, v = u % C.G; int bh, qb;
            if (C.G == 256) { const int s = v & 3; bh = v >> 2; qb = (i == 0) ? s : (i == 1) ? 7 - s : (i == 2) ? 8 + s : 15 - s; } else { bh = u >> 4; qb = u & 15; }
            fox_unit(C, lds, bh >> 3, bh & 7, qb); }
    } SEAM(9);
    if (IN(10)) { pg8::Gemm g{CAT, (const bf16*)(ws + WS_WO) + (size_t)DM * DM, T, DM, DM}; pg8::StaticOrder S; S.init(T, DM, C.G, (int)blockIdx.x);
        pg8::EpiRes E{C.out, C.out, XB, SSP, DM};
        pg8::gemm_phase<pg8::EpiRes, pg8::StaticOrder, PG8_ALIGN, PG8_SP2>(lds, g, S, E); } SEAM(10);
    if (IN(11)) { pg8::Gemm g{XB, (const bf16*)(ws + WS_W1) + (size_t)DM * FF, T, FF, DM}; pg8::StaticOrder S; S.init(T, FF, C.G, (int)blockIdx.x);
        pg8::EpiAct<2> E{HB, FF, SSP, 1.0f / DM, EPS};
        pg8::gemm_phase<pg8::EpiAct<2>, pg8::StaticOrder, PG8_ALIGN, PG8_SP2>(lds, g, S, E); } SEAM(11);
    if (IN(12)) { pg8::Gemm g{HB, (const bf16*)(ws + WS_W2) + (size_t)DM * FF, T, DM, FF}; pg8::StaticOrder S; S.init(T, DM, C.G, (int)blockIdx.x);
        pg8::EpiRes E{C.out, C.out, XB, SSP, DM};
        pg8::gemm_phase<pg8::EpiRes, pg8::StaticOrder, PG8_ALIGN, PG8_SP2>(lds, g, S, E); }
#undef IN
#undef SEAM
}

extern "C" void kernel_launch(void* const* d_in, const int* in_sizes, int n_in, void* d_out, int out_size, void* d_ws, size_t ws_size, hipStream_t stream) {
    static int grid = 0;
    if (grid == 0) {
        if (n_in != 23 || in_sizes[0] != T * DM || out_size != T * DM || ws_size < WS_END) { fprintf(stderr, "kernel_launch: unexpected shapes (n_in %d, in0 %d, out %d, ws %zu)\n", n_in, n_in > 0 ? in_sizes[0] : -1, out_size, ws_size); grid = -1; return; }
        int dev = 0, cus = 0, per_cu = 0;
        if (hipGetDevice(&dev) != hipSuccess || hipDeviceGetAttribute(&cus, hipDeviceAttributeMultiprocessorCount, dev) != hipSuccess) { grid = -1; return; }
        if (hipFuncSetAttribute((const void*)fwd_kernel, hipFuncAttributeMaxDynamicSharedMemorySize, LDS_BYTES) != hipSuccess) { fprintf(stderr, "kernel_launch: hipFuncSetAttribute failed\n"); grid = -1; return; }
        if (hipOccupancyMaxActiveBlocksPerMultiprocessor(&per_cu, (const void*)fwd_kernel, NWAVES * 64, LDS_BYTES) != hipSuccess || per_cu < 1) { fprintf(stderr, "kernel_launch: occupancy query says %d\n", per_cu); per_cu = 1; }
        (void)hipGetLastError();
        grid = cus;
    }
    if (grid < 0) return;
    Args a{};
    for (int i = 0; i < 23; ++i) a.in[i] = (const float*)d_in[i];
    a.out = (float*)d_out; a.ws = (unsigned char*)d_ws;
#if MK_MULTI
    for (int p = 0; p < NPHASE; ++p) { a.ph_lo = p; a.ph_hi = p + 1; hipLaunchKernelGGL(fwd_kernel, dim3(grid), dim3(NWAVES * 64), LDS_BYTES, stream, a); }
#else
    a.ph_lo = 0; a.ph_hi = NPHASE;
    void* kargs[] = {&a};
    hipError_t e = hipLaunchCooperativeKernel((const void*)fwd_kernel, dim3(grid), dim3(NWAVES * 64), kargs, LDS_BYTES, stream);
    if (e != hipSuccess) fprintf(stderr, "kernel_launch: cooperative launch failed: %s (grid %d)\n", hipGetErrorString(e), grid);
#endif
}
```

```cpp
#include <hip/hip_runtime.h>
#include <hip/hip_cooperative_groups.h>
#include <cstdio>
#include <cstdint>
namespace cg = cooperative_groups;
#ifndef MK_MULTI
#define MK_MULTI 0
#endif
namespace pg8 {
#define PG8_LAS __attribute__((address_space(3)))
typedef unsigned short bf16_t;
typedef short bf16x8 __attribute__((ext_vector_type(8)));
typedef float f32x4 __attribute__((ext_vector_type(4)));
typedef unsigned u32x4 __attribute__((ext_vector_type(4)));
constexpr int BM = 256, BK = 64, HALF = 128, HTB = HALF * BK * 2  , STAGE_BYTES = 8 * HTB, NXCD = 8, WGM = 8;

__host__ __device__ __forceinline__ int lds_byte(int r, int c) { const int st = (r >> 4) * 2 + (c >> 5), rr = r & 15, cc = c & 31, ob = rr * 64 + cc * 2; return st * 1024 + (ob ^ (((ob >> 9) & 1) << 5)); }
__host__ __device__ __forceinline__ void stage_rc(int b, int& R, int& C) { const int st = b / 1024, sb = b % 1024, swz = sb ^ (((sb >> 9) & 1) << 5); R = (st >> 1) * 16 + swz / 64; C = (st & 1) * 32 + (swz % 64) / 2; }
__host__ __device__ __forceinline__ int perm32(int rho) { const int n = rho >> 4, i = rho & 15; return 8 * (i >> 2) + 4 * n + (i & 3); }

struct Unit { int pm, pn; };
struct Gemm { const bf16_t* A; const bf16_t* Bt; int M, N, K; };

struct StaticOrder {
    int nM, nN, nwg, G, c;
    __host__ __device__ void init(int M, int N, int G_, int c_) { nM = M / BM; nN = N / BM; nwg = nM * nN; G = G_; c = c_; }
    __host__ __device__ bool next(int i, Unit& u) const {
        const long L = (long)i * G + c; if (L >= nwg) return false;
        int wgid = (int)L; { const int q = nwg / NXCD, r = nwg % NXCD, xcd = wgid % NXCD, off = wgid / NXCD; wgid = (xcd < r ? xcd * (q + 1) : r * (q + 1) + (xcd - r) * q) + off; }
        const int nig = WGM * nN, gid = wgid / nig, fm = gid * WGM, gsz = (nM - fm) < WGM ? (nM - fm) : WGM;
        u.pm = fm + ((wgid % nig) % gsz); u.pn = (wgid % nig) / gsz; return true;
    }
    __device__ __forceinline__ void a_ready(const Unit&) const {}
    __device__ __forceinline__ void done(const Unit&) const {}
};

__device__ __forceinline__ unsigned cvt_pk_bf16(float lo, float hi) { unsigned r; asm volatile("v_cvt_pk_bf16_f32 %0, %1, %2" : "=v"(r) : "v"(lo), "v"(hi)); return r; }
typedef float f32x2 __attribute__((ext_vector_type(2)));
typedef float f32x2 __attribute__((ext_vector_type(2)));
typedef unsigned u32x2 __attribute__((ext_vector_type(2)));
__device__ __forceinline__ float gelu_tanh_f(float x) {
    const float z = 0.7978845608028654f * (x + 0.044715f * x * x * x);
    const float e = __builtin_amdgcn_exp2f(-2.0f * 1.4426950408889634f * z);
    return x * __builtin_amdgcn_rcpf(1.0f + e);
}
template <int ACT  > struct EpiAct {
    static constexpr bool PERM = true, AFTER_DRAIN = false;
    bf16_t* O; int ldc; const float* ssp; float inv_n; float eps;
    __device__ __forceinline__ void operator()(const f32x4 (&acc)[2][2][4][2], const Unit& u, int wr, int wc, int fr, int fq) const {
        const int row0 = u.pm * BM + wr * 64 + fr, col0 = u.pn * BM + wc * 32 + 8 * fq;
        const bool gel = (ACT == 1) && (u.pn >= 2) && (u.pn < 4);
#pragma unroll
        for (int ai = 0; ai < 2; ++ai)
#pragma unroll
            for (int m = 0; m < 4; ++m) {
                const int row = row0 + ai * HALF + m * 16;
                const f32x4* sp = (const f32x4*)(ssp + (size_t)row * 16);
                const f32x4 s0 = sp[0], s1 = sp[1], s2 = sp[2], s3 = sp[3];
                const float ss = ((s0[0] + s0[1]) + (s0[2] + s0[3])) + ((s1[0] + s1[1]) + (s1[2] + s1[3])) + ((s2[0] + s2[1]) + (s2[2] + s2[3])) + ((s3[0] + s3[1]) + (s3[2] + s3[3]));
                const float rs = 1.0f / sqrtf(ss * inv_n + eps);
                bf16_t* rowp = O + (size_t)row * ldc + col0;
#pragma unroll
                for (int bj = 0; bj < 2; ++bj) {
                    f32x4 v0 = acc[ai][bj][m][0] * rs, v1 = acc[ai][bj][m][1] * rs;
                    if (ACT == 1) { if (gel) {
#pragma unroll
                        for (int e = 0; e < 4; ++e) { v0[e] = gelu_tanh_f(v0[e]); v1[e] = gelu_tanh_f(v1[e]); } } }
                    if (ACT == 2) {
#pragma unroll
                        for (int e = 0; e < 4; ++e) { const float a = fmaxf(v0[e], 0.f), b = fmaxf(v1[e], 0.f); v0[e] = a * a; v1[e] = b * b; } }
                    u32x4 w; w.x = cvt_pk_bf16(v0[0], v0[1]); w.y = cvt_pk_bf16(v0[2], v0[3]); w.z = cvt_pk_bf16(v1[0], v1[1]); w.w = cvt_pk_bf16(v1[2], v1[3]);
                    *(u32x4*)(rowp + bj * HALF) = w; }
            }
    }
};
template <bool BASE_F32, bool LAST> struct EpiResB {
    static constexpr bool PERM = true, AFTER_DRAIN = false;
    const float* basef; bf16_t* xb; float* ssp; float* out; int ldc;
    __device__ __forceinline__ void operator()(const f32x4 (&acc)[2][2][4][2], const Unit& u, int wr, int wc, int fr, int fq) const {
        const int row0 = u.pm * BM + wr * 64 + fr, col0 = u.pn * BM + wc * 32 + 8 * fq;
#pragma unroll
        for (int ai = 0; ai < 2; ++ai) {
            f32x4 pf[BASE_F32 ? 4 : 1][2][2]; u32x4 pb[BASE_F32 ? 1 : 4][2];
#pragma unroll
            for (int m = 0; m < 4; ++m) { const size_t off = (size_t)(row0 + ai * HALF + m * 16) * ldc + col0;
#pragma unroll
                for (int bj = 0; bj < 2; ++bj) {
                    if (BASE_F32) { pf[BASE_F32 ? m : 0][bj][0] = *(const f32x4*)(basef + off + bj * HALF); pf[BASE_F32 ? m : 0][bj][1] = *(const f32x4*)(basef + off + bj * HALF + 4); }
                    else pb[BASE_F32 ? 0 : m][bj] = *(const u32x4*)(xb + off + bj * HALF); } }
            asm volatile("" ::: "memory");
#pragma unroll
            for (int m = 0; m < 4; ++m) {
                const int row = row0 + ai * HALF + m * 16; const size_t off = (size_t)row * ldc + col0; float ss = 0.f;
#pragma unroll
                for (int bj = 0; bj < 2; ++bj) {
                    f32x4 b0, b1;
                    if (BASE_F32) { b0 = pf[BASE_F32 ? m : 0][bj][0]; b1 = pf[BASE_F32 ? m : 0][bj][1]; }
                    else { const u32x4 w = pb[BASE_F32 ? 0 : m][bj];
                        b0 = (f32x4){__uint_as_float(w.x << 16), __uint_as_float(w.x & 0xffff0000u), __uint_as_float(w.y << 16), __uint_as_float(w.y & 0xffff0000u)};
                        b1 = (f32x4){__uint_as_float(w.z << 16), __uint_as_float(w.z & 0xffff0000u), __uint_as_float(w.w << 16), __uint_as_float(w.w & 0xffff0000u)}; }
                    const f32x4 v0 = b0 + acc[ai][bj][m][0], v1 = b1 + acc[ai][bj][m][1];
                    if (LAST) { *(f32x4*)(out + off + bj * HALF) = v0; *(f32x4*)(out + off + bj * HALF + 4) = v1; }
                    else { ss += ((v0[0] * v0[0] + v0[1] * v0[1]) + (v0[2] * v0[2] + v0[3] * v0[3])) + ((v1[0] * v1[0] + v1[1] * v1[1]) + (v1[2] * v1[2] + v1[3] * v1[3]));
                        u32x4 w; w.x = cvt_pk_bf16(v0[0], v0[1]); w.y = cvt_pk_bf16(v0[2], v0[3]); w.z = cvt_pk_bf16(v1[0], v1[1]); w.w = cvt_pk_bf16(v1[2], v1[3]);
                        *(u32x4*)(xb + off + bj * HALF) = w; } }
                if (!LAST) { ss += __shfl_xor(ss, 16); ss += __shfl_xor(ss, 32); if (fq == 0) ssp[(size_t)row * 16 + u.pn * 4 + wc] = ss; }
            }
            asm volatile("" ::: "memory");
        }
    }
};
template <class Epi, class Sched, bool ALIGN_EPI = false, bool SP2 = false>
__device__ __forceinline__ void gemm_phase(PG8_LAS unsigned char* lds, const Gemm g, const Sched& S, const Epi& E) {
    const int tid = threadIdx.x, wid = __builtin_amdgcn_readfirstlane(tid >> 6), lane = tid & 63, wr = wid >> 2, wc = wid & 3, fr = lane & 15, fq = lane >> 4;
    const int K = g.K, nt = K / BK;
    unsigned voffA[2], voffB[2];
#pragma unroll
    for (int i = 0; i < 2; ++i) { int R, C; stage_rc(tid * 16 + i * 8192, R, C); const int Rb = Epi::PERM ? ((R & ~31) + perm32(R & 31)) : R;
        voffA[i] = (unsigned)(R * K + C) * 2u; voffB[i] = (unsigned)(Rb * K + C) * 2u; }
    const size_t kstep = (size_t)(BK * 2);
    const size_t hstep = (size_t)HALF * K * 2;
    const size_t tstep = 2 * hstep;
    const unsigned ldsw = (unsigned)wid * 1024u;
    const int aoff = lds_byte(wr * 64 + fr, fq * 8), boff = lds_byte(wc * 32 + fr, fq * 8);
#define PG8_SA(b, h) (((b) * 2 + (h)) * HTB)
#define PG8_SB(b, h) ((4 + (b) * 2 + (h)) * HTB)
#define PG8_STAGE(bufoff, gbase, voff) do { _Pragma("unroll") for (int _i = 0; _i < 2; ++_i) \
        __builtin_amdgcn_global_load_lds((const unsigned*)((const char*)(gbase) + (voff)[_i]), (PG8_LAS unsigned*)(lds + (bufoff) + ldsw + _i * 8192), 16, 0, 0); } while (0)
#define PG8_LDA(dst, b, h) do { _Pragma("unroll") for (int m = 0; m < 4; ++m) _Pragma("unroll") for (int k = 0; k < 2; ++k) dst[m][k] = *(const PG8_LAS bf16x8*)(lds + PG8_SA(b, h) + aoff + m * 2048 + k * 1024); } while (0)
#define PG8_LDB(dst, b, h) do { _Pragma("unroll") for (int n = 0; n < 2; ++n) _Pragma("unroll") for (int k = 0; k < 2; ++k) dst[n][k] = *(const PG8_LAS bf16x8*)(lds + PG8_SB(b, h) + boff + n * 2048 + k * 1024); } while (0)
#define PG8_MMA(ai, bj, At, Bt) do { __builtin_amdgcn_s_setprio(1); _Pragma("unroll") for (int m = 0; m < 4; ++m) _Pragma("unroll") for (int n = 0; n < 2; ++n) _Pragma("unroll") for (int k = 0; k < 2; ++k) \
        acc[ai][bj][m][n] = __builtin_amdgcn_mfma_f32_16x16x32_bf16(Bt[n][k], At[m][k], acc[ai][bj][m][n], 0, 0, 0); __builtin_amdgcn_s_setprio(0); } while (0)
#define PG8_WAIT_V(n) asm volatile("s_waitcnt vmcnt(" #n ")" ::: "memory")
#define PG8_WAIT_L(n) asm volatile("s_waitcnt lgkmcnt(" #n ")" ::: "memory")
#define PG8_BAR __builtin_amdgcn_s_barrier()
#define PG8_SCHED __builtin_amdgcn_sched_barrier(0)
    Unit cur, nxt; int ui = 0;
    if (!S.next(0, cur)) return;
    f32x4 acc[2][2][4][2];
#pragma unroll
    for (int a = 0; a < 2; ++a)
#pragma unroll
        for (int b = 0; b < 2; ++b)
#pragma unroll
            for (int m = 0; m < 4; ++m)
#pragma unroll
                for (int n = 0; n < 2; ++n) acc[a][b][m][n] = (f32x4){0.f, 0.f, 0.f, 0.f};
    bf16x8 At[4][2], B0[2][2], B1[2][2];
    const char* cA = (const char*)g.A + (size_t)cur.pm * tstep; const char* cB = (const char*)g.Bt + (size_t)cur.pn * tstep;
    S.a_ready(cur);
    if constexpr (SP2) {
        PG8_STAGE(PG8_SB(0, 0), cB, voffB); PG8_STAGE(PG8_SB(0, 1), cB + hstep, voffB); PG8_STAGE(PG8_SA(0, 0), cA, voffA); PG8_STAGE(PG8_SA(0, 1), cA + hstep, voffA);
        if (wr == 1) PG8_BAR;
        PG8_WAIT_V(2); PG8_BAR;
        PG8_STAGE(PG8_SB(1, 0), cB + kstep, voffB); PG8_STAGE(PG8_SA(1, 0), cA + kstep, voffA); PG8_STAGE(PG8_SB(1, 1), cB + hstep + kstep, voffB);
        PG8_WAIT_V(6); PG8_BAR;
    } else {
        PG8_STAGE(PG8_SB(0, 0), cB, voffB); PG8_STAGE(PG8_SA(0, 0), cA, voffA); PG8_STAGE(PG8_SB(0, 1), cB + hstep, voffB); PG8_STAGE(PG8_SA(0, 1), cA + hstep, voffA);
        if (wr == 1) PG8_BAR;
        PG8_WAIT_V(4); PG8_BAR;
        PG8_STAGE(PG8_SB(1, 0), cB + kstep, voffB); PG8_STAGE(PG8_SA(1, 0), cA + kstep, voffA); PG8_STAGE(PG8_SB(1, 1), cB + hstep + kstep, voffB);
        PG8_WAIT_V(6); PG8_BAR;
    }
    for (;;) {
        const bool has_next = S.next(ui + 1, nxt);
        const char* nA = has_next ? (const char*)g.A + (size_t)nxt.pm * tstep : cA; const char* nB = has_next ? (const char*)g.Bt + (size_t)nxt.pn * tstep : cB;
        for (int t = 0; t < nt; t += 2) {
            const bool last = (t == nt - 2);
            const char* a1 = cA + (size_t)(t + 1) * kstep;
            const char* a2 = last ? nA : cA + (size_t)(t + 2) * kstep; const char* b2 = last ? nB : cB + (size_t)(t + 2) * kstep;
            const char* a3 = a2 + kstep; const char* b3 = b2 + kstep;
            if (last && has_next) S.a_ready(nxt);
            if constexpr (SP2) {
            PG8_LDB(B0, 0, 0); PG8_LDB(B1, 0, 1); PG8_SCHED; PG8_LDA(At, 0, 0); PG8_STAGE(PG8_SA(1, 1), a1 + hstep, voffA);
            PG8_WAIT_V(8); PG8_WAIT_L(0); PG8_BAR; PG8_MMA(0, 0, At, B0); PG8_MMA(0, 1, At, B1); PG8_BAR; PG8_SCHED;
            PG8_LDA(At, 0, 1); PG8_STAGE(PG8_SB(0, 0), b2, voffB); PG8_STAGE(PG8_SB(0, 1), b2 + hstep, voffB); PG8_STAGE(PG8_SA(0, 0), a2, voffA);
            PG8_WAIT_V(8); PG8_WAIT_L(0); PG8_BAR; PG8_MMA(1, 0, At, B0); PG8_MMA(1, 1, At, B1); PG8_BAR; PG8_SCHED;
            PG8_LDB(B0, 1, 0); PG8_LDB(B1, 1, 1); PG8_SCHED; PG8_LDA(At, 1, 0); PG8_STAGE(PG8_SA(0, 1), a2 + hstep, voffA);
            PG8_WAIT_V(8); PG8_WAIT_L(0); PG8_BAR; PG8_MMA(0, 0, At, B0); PG8_MMA(0, 1, At, B1); PG8_BAR; PG8_SCHED;
            PG8_LDA(At, 1, 1); PG8_STAGE(PG8_SB(1, 0), b3, voffB); PG8_STAGE(PG8_SB(1, 1), b3 + hstep, voffB); PG8_STAGE(PG8_SA(1, 0), a3, voffA);
            PG8_WAIT_V(8); PG8_WAIT_L(0); PG8_BAR; PG8_MMA(1, 0, At, B0); PG8_MMA(1, 1, At, B1); PG8_BAR; PG8_SCHED;
            } else {
            PG8_LDB(B0, 0, 0); PG8_SCHED; PG8_LDA(At, 0, 0); PG8_STAGE(PG8_SA(1, 1), a1 + hstep, voffA);
            PG8_WAIT_L(8); PG8_BAR; PG8_WAIT_L(0); PG8_MMA(0, 0, At, B0); PG8_BAR; PG8_SCHED;
            PG8_LDB(B1, 0, 1); PG8_STAGE(PG8_SB(0, 0), b2, voffB);
            PG8_BAR; PG8_WAIT_L(0); PG8_MMA(0, 1, At, B1); PG8_BAR;
            PG8_LDA(At, 0, 1); PG8_STAGE(PG8_SA(0, 0), a2, voffA);
            PG8_BAR; PG8_WAIT_L(0); PG8_MMA(1, 0, At, B0); PG8_BAR; PG8_SCHED;
            PG8_STAGE(PG8_SB(0, 1), b2 + hstep, voffB);
            PG8_WAIT_V(6); PG8_BAR; PG8_MMA(1, 1, At, B1); PG8_BAR;
            PG8_LDB(B0, 1, 0); PG8_SCHED; PG8_LDA(At, 1, 0); PG8_STAGE(PG8_SA(0, 1), a2 + hstep, voffA);
            PG8_WAIT_L(8); PG8_BAR; PG8_WAIT_L(0); PG8_MMA(0, 0, At, B0); PG8_BAR; PG8_SCHED;
            PG8_LDB(B1, 1, 1); PG8_STAGE(PG8_SB(1, 0), b3, voffB);
            PG8_BAR; PG8_WAIT_L(0); PG8_MMA(0, 1, At, B1); PG8_BAR;
            PG8_LDA(At, 1, 1); PG8_STAGE(PG8_SA(1, 0), a3, voffA);
            PG8_BAR; PG8_WAIT_L(0); PG8_MMA(1, 0, At, B0); PG8_BAR; PG8_SCHED;
            PG8_STAGE(PG8_SB(1, 1), b3 + hstep, voffB);
            PG8_WAIT_V(6); PG8_BAR; PG8_MMA(1, 1, At, B1); PG8_BAR;
            }
        }
        if constexpr (ALIGN_EPI) { if (wr == 0) PG8_BAR; }
        if constexpr (!Epi::AFTER_DRAIN) { E(acc, cur, wr, wc, fr, fq); S.done(cur); }
        if (!has_next) break;
#pragma unroll
        for (int a = 0; a < 2; ++a)
#pragma unroll
            for (int b = 0; b < 2; ++b)
#pragma unroll
                for (int m = 0; m < 4; ++m)
#pragma unroll
                    for (int n = 0; n < 2; ++n) acc[a][b][m][n] = (f32x4){0.f, 0.f, 0.f, 0.f};
        cur = nxt; cA = nA; cB = nB; ++ui;
        if constexpr (ALIGN_EPI) { if (wr == 1) PG8_BAR; }
    }
    PG8_WAIT_V(0);
    if constexpr (!ALIGN_EPI) { if (wr == 0) PG8_BAR; }
    PG8_BAR;
    if constexpr (Epi::AFTER_DRAIN) { E.fused(acc, cur, wr, wc, fr, fq, lds, wid, lane); S.done(cur); }
#undef PG8_SA
#undef PG8_SB
#undef PG8_STAGE
#undef PG8_LDA
#undef PG8_LDB
#undef PG8_MMA
#undef PG8_WAIT_V
#undef PG8_WAIT_L
#undef PG8_BAR
#undef PG8_SCHED
}
}
#ifndef PG8_SP2
#define PG8_SP2 true
#endif
#ifndef PG8_ALIGN
#define PG8_ALIGN true
#endif
#define LAS __attribute__((address_space(3)))
typedef unsigned short bf16;
typedef short bf16x8 __attribute__((ext_vector_type(8)));
typedef float f32x4 __attribute__((ext_vector_type(4)));
typedef float f32x16 __attribute__((ext_vector_type(16)));
typedef unsigned u32x4 __attribute__((ext_vector_type(4)));
typedef unsigned u32x2 __attribute__((ext_vector_type(2)));
constexpr int NB = 8, SEQ = 4096, DM = 1024, T = NB * SEQ, FF = 4096, MEMN = 256, MROWS = NB * MEMN;
constexpr int NA = 1536, NQ = 2048, NINB = 2056;
constexpr float EPS = 1e-6f, LOG2E = 1.4426950408889634f;
constexpr int NWAVES = 8;
constexpr int LDS_BYTES = 147456;
constexpr size_t MiB = 1u << 20;
constexpr size_t WS_WA = 1 * MiB, WS_WB = 4 * MiB, WS_WF = 8 * MiB, WS_WO = 9 * MiB, WS_W1 = 13 * MiB, WS_W2 = 29 * MiB, WS_WKV = 45 * MiB, WS_WR = 49 * MiB, WS_WI = 49 * MiB + 512 * 1024;
constexpr size_t WS_MEMB = 50 * MiB, WS_MEMSS = 54 * MiB, WS_KVRAW = 55 * MiB, WS_KN = 63 * MiB, WS_VT = 67 * MiB, WS_SSP = 71 * MiB, WS_AP = 73 * MiB, WS_HE = 74 * MiB, WS_CL = 75 * MiB, WS_CTOT = 76 * MiB;
constexpr size_t WS_XB = 80 * MiB, WS_H = 144 * MiB, WS_PROJ = 144 * MiB, WS_CAT = 272 * MiB, WS_QN = 336 * MiB, WS_KNF = 368 * MiB, WS_VTF = 400 * MiB, WS_END = 432 * MiB;

struct Ctx { const float* x; float* out; unsigned char* ws; int vcu, G; };
struct Args { const float* in[23]; float* out; unsigned char* ws; int ph_lo, ph_hi; };
constexpr size_t WS_PAR = 77 * MiB;
constexpr int PQG = 0, PKG = 256, PCW = 512, PCB = 2560, PBR = 3072, PBI = 3584, PLAM = 4096, PBF = 4608, PFQG = 4624, PFKG = 4688, PAR_N = 4752;
#define PHASE_IDS() int tid = threadIdx.x; asm volatile("" : "+v"(tid)); const int lane = tid & 63; const int wid = __builtin_amdgcn_readfirstlane(tid >> 6); unsigned char* ws = C.ws; asm volatile("" : "+s"(ws)); const float* par = (const float*)(ws + WS_PAR)
__device__ __forceinline__ float bf2f(unsigned short b) { return __uint_as_float((unsigned)b << 16); }
typedef __bf16 bf16x2_t __attribute__((ext_vector_type(2))); typedef float f32x2_t __attribute__((ext_vector_type(2)));
__device__ __forceinline__ unsigned pk2(float lo, float hi) { f32x2_t v = {lo, hi}; bf16x2_t b = __builtin_convertvector(v, bf16x2_t); return __builtin_bit_cast(unsigned, b); }
__device__ __forceinline__ unsigned short f2bf(float f) { return (unsigned short)(pk2(f, 0.f) & 0xffffu); }
__device__ __forceinline__ float wave_sum(float v) {
#pragma unroll
    for (int o = 1; o < 64; o <<= 1) v += __shfl_xor(v, o);
    return v;
}
__device__ __forceinline__ float wave_max(float v) {
#pragma unroll
    for (int o = 1; o < 64; o <<= 1) v = fmaxf(v, __shfl_xor(v, o));
    return v;
}
__device__ __forceinline__ int crow(int r, int hi) { return (r & 3) + 8 * (r >> 2) + 4 * hi; }
__device__ __forceinline__ int kperm(int p) { return 8 * ((p & 7) >> 2) + 4 * (p >> 3) + (p & 3); }
__device__ __forceinline__ float sigmoid_f(float x) { return __builtin_amdgcn_rcpf(1.0f + __builtin_amdgcn_exp2f(-LOG2E * x)); }

__device__ __forceinline__ void tr_item(const float* W, int ldw, int col0, bf16* WT, int K, int row0, const float* gain, int kb, int nb, LAS float* scr, int lane) {
    const int k0 = 64 * kb, n0 = 32 * nb;
#pragma unroll 8
    for (int i = 0; i < 32; ++i) { const int kk = 2 * i + (lane >> 5); const float g = gain ? gain[k0 + kk] : 1.0f;
        scr[kk * 33 + (lane & 31)] = W[(size_t)(k0 + kk) * ldw + col0 + n0 + (lane & 31)] * g; }
    asm volatile("s_waitcnt lgkmcnt(0)" ::: "memory");
    const int c = lane & 7;
#pragma unroll
    for (int j = 0; j < 4; ++j) { const int n = (lane >> 3) + 8 * j; const LAS float* s = scr + (8 * c) * 33 + n;
        u32x4 o; o.x = pk2(s[0 * 33], s[1 * 33]); o.y = pk2(s[2 * 33], s[3 * 33]); o.z = pk2(s[4 * 33], s[5 * 33]); o.w = pk2(s[6 * 33], s[7 * 33]);
        *(u32x4*)(WT + (size_t)(row0 + n0 + n) * K + k0 + 8 * c) = o; }
    asm volatile("s_waitcnt lgkmcnt(0)" ::: "memory");
}
__device__ __forceinline__ void row_to_bf16(const float* xrow, bf16* orow, float* ssrow, int lane) {
    const f32x4* xr = (const f32x4*)xrow + lane; f32x4 v[4]; float s = 0.f;
#pragma unroll
    for (int j = 0; j < 4; ++j) { v[j] = xr[64 * j]; s += (v[j][0] * v[j][0] + v[j][1] * v[j][1]) + (v[j][2] * v[j][2] + v[j][3] * v[j][3]); }
    s = wave_sum(s);
    u32x2* o = (u32x2*)orow + lane;
#pragma unroll
    for (int j = 0; j < 4; ++j) { u32x2 w; w.x = pk2(v[j][0], v[j][1]); w.y = pk2(v[j][2], v[j][3]); o[64 * j] = w; }
    if (lane < 16) ssrow[lane] = (lane == 0) ? s : 0.f;
}
__device__ __forceinline__ void p0_prologue(const Args& A, const Ctx& C, LAS unsigned char* lds) {
    PHASE_IDS();
    LAS float* scr = (LAS float*)(lds + wid * 16384);
    const int gw = C.vcu * NWAVES + wid, NGW = C.G * NWAVES;
    if (C.vcu == 0) { float* pw = (float*)(ws + WS_PAR);
        for (int e = tid; e < PAR_N; e += 512) { float v = 0.f;
            if (e < PKG) v = A.in[5][e - PQG]; else if (e < PCW) v = A.in[6][e - PKG]; else if (e < PCB) v = A.in[12][e - PCW]; else if (e < PBR) v = A.in[13][e - PCB];
            else if (e < PBI) v = A.in[15][e - PBR]; else if (e < PLAM) v = A.in[17][e - PBI]; else if (e < PBF) v = A.in[18][e - PLAM]; else if (e < PBF + 8) v = A.in[20][e - PBF];
            else if (e < PFQG) v = 0.f; else if (e < PFKG) v = A.in[21][e - PFQG]; else v = A.in[22][e - PFKG];
            pw[e] = v; } }
    constexpr int I0 = 16 * 48, I1 = 16 * 48, I2 = 16 * 16, I3 = 16 * 32, I5 = 16 * 128, I7 = 64 * 32, I9 = 16 * 32, I11 = 16;
    constexpr int NITEMS = I0 + I1 + I2 + 2 * I3 + 2 * I5 + 2 * I7 + 2 * I9 + 2 * I11;
    for (int it = gw; it < NITEMS; it += NGW) {
        int r = it;
        if (r < I0) { tr_item(A.in[11], NA, 0, (bf16*)(ws + WS_WA), DM, 0, A.in[2], r / 48, r % 48, scr, lane); continue; } r -= I0;
        if (r < I1) { tr_item(A.in[19], NINB, 0, (bf16*)(ws + WS_WB), DM, 0, A.in[2] + DM, r / 48, r % 48, scr, lane); continue; } r -= I1;
        if (r < I2) { tr_item(A.in[19], NINB, 1544, (bf16*)(ws + WS_WB), DM, 1536, A.in[2] + DM, r / 16, r % 16, scr, lane); continue; } r -= I2;
        if (r < 2 * I3) { const int l = r / I3; r %= I3; tr_item(A.in[7] + (size_t)l * DM * DM, DM, 0, (bf16*)(ws + WS_WO) + (size_t)l * DM * DM, DM, 0, nullptr, r / 32, r % 32, scr, lane); continue; } r -= 2 * I3;
        if (r < 2 * I5) { const int l = r / I5; r %= I5; tr_item(A.in[9] + (size_t)l * DM * FF, FF, 0, (bf16*)(ws + WS_W1) + (size_t)l * DM * FF, DM, 0, A.in[8] + l * DM, r / 128, r % 128, scr, lane); continue; } r -= 2 * I5;
        if (r < 2 * I7) { const int l = r / I7; r %= I7; tr_item(A.in[10] + (size_t)l * DM * FF, DM, 0, (bf16*)(ws + WS_W2) + (size_t)l * DM * FF, FF, 0, nullptr, r / 32, r % 32, scr, lane); continue; } r -= 2 * I7;
        if (r < 2 * I9) { const int l = r / I9; r %= I9; tr_item(A.in[4] + (size_t)l * DM * DM, DM, 0, (bf16*)(ws + WS_WKV) + (size_t)l * DM * DM, DM, 0, A.in[3] + l * DM, r / 32, r % 32, scr, lane); continue; } r -= 2 * I9;
        if (r < I11) { tr_item(A.in[14] + (size_t)(r >> 1) * 4096, 64, 0, (bf16*)(ws + WS_WR) + (size_t)(r >> 1) * 4096, 64, 0, nullptr, 0, r & 1, scr, lane); continue; } r -= I11;
        tr_item(A.in[16] + (size_t)(r >> 1) * 4096, 64, 0, (bf16*)(ws + WS_WI) + (size_t)(r >> 1) * 4096, 64, 0, nullptr, 0, r & 1, scr, lane);
    }
    { bf16* wf = (bf16*)(ws + WS_WF); const float* wb = A.in[19]; const float* g = A.in[2] + DM;
      for (int e = (C.vcu * 512 + tid); e < 16 * DM; e += C.G * 512) { const int n = e >> 10, k = e & 1023; wf[e] = (n < 8) ? f2bf(wb[(size_t)k * NINB + 1536 + n] * g[k]) : (unsigned short)0; } }
    for (int m = gw; m < T; m += NGW) row_to_bf16(A.in[0] + (size_t)m * DM, (bf16*)(ws + WS_XB) + (size_t)m * DM, (float*)(ws + WS_SSP) + (size_t)m * 16, lane);
    for (int m = gw; m < MROWS; m += NGW) row_to_bf16(A.in[1] + (size_t)m * DM, (bf16*)(ws + WS_MEMB) + (size_t)m * DM, (float*)(ws + WS_MEMSS) + (size_t)m * 16, lane);
}

template <bool FINAL> __device__ __forceinline__ void lru_unit(const Ctx& C, LAS unsigned char* lds, int b, int ck) {
    PHASE_IDS();
    LAS bf16* UC = (LAS bf16*)lds;
    LAS float* Aa = (LAS float*)(lds + 16640);
    LAS float* Bb = (LAS float*)(lds + 16640 + 32768);
    const bf16* WRt = (const bf16*)(ws + WS_WR) + wid * 4096; const bf16* WIt = (const bf16*)(ws + WS_WI) + wid * 4096;
    bf16x8 br[4][2], bi[4][2];
#pragma unroll
    for (int j = 0; j < 4; ++j)
#pragma unroll
        for (int kk = 0; kk < 2; ++kk) { const int o = (16 * j + (lane & 15)) * 64 + 32 * kk + 8 * (lane >> 4); br[j][kk] = *(const bf16x8*)(WRt + o); bi[j][kk] = *(const bf16x8*)(WIt + o); }
    float cbr[4], cbi[4], csp[4];
#pragma unroll
    for (int j = 0; j < 4; ++j) { const int d = wid * 64 + 16 * j + (lane & 15); cbr[j] = par[PBR + d]; cbi[j] = par[PBI + d];
        const float lam = par[PLAM + d]; const float sp = (lam < -20.f) ? -lam : log1pf(expf(-lam)); csp[j] = 8.0f * sp * LOG2E; }
    const int ch = tid;
    const float cw0 = par[PCW + ch], cw1 = par[PCW + 512 + ch], cw2 = par[PCW + 1024 + ch], cw3 = par[PCW + 1536 + ch], cb = par[PCB + ch];
    const size_t t0 = (size_t)b * SEQ + (size_t)ck * 128;
    const bf16* proj = (const bf16*)(ws + WS_PROJ);
    const bf16* up = proj + t0 * NA + ch;
    float um3 = 0.f, um2 = 0.f, um1 = 0.f;
    if (ck > 0) { um3 = bf2f(*(up - 3 * NA)); um2 = bf2f(*(up - 2 * NA)); um1 = bf2f(*(up - NA)); }
    float h = 0.f, P = 1.f;
    if (FINAL) { const float* ap = (const float*)(ws + WS_AP) + (size_t)b * 32 * 512 + ch; const float* he = (const float*)(ws + WS_HE) + (size_t)b * 32 * 512 + ch;
        for (int k = 0; k < ck; ++k) h = ap[k * 512] * h + he[k * 512]; }
    bf16* cat = (bf16*)(ws + WS_CAT);
    unsigned short un[16], gn[16];
#pragma unroll
    for (int tt = 0; tt < 16; ++tt) { un[tt] = up[(size_t)tt * NA]; if (FINAL) gn[tt] = up[(size_t)tt * NA + 512]; }
#pragma unroll 1
    for (int st = 0; st < 8; ++st) {
        float uc[16], gt[16];
#pragma unroll
        for (int tt = 0; tt < 16; ++tt) { const float u0 = bf2f(un[tt]); uc[tt] = cw0 * um3 + cw1 * um2 + cw2 * um1 + cw3 * u0 + cb; um3 = um2; um2 = um1; um1 = u0; UC[tt * 520 + ch] = f2bf(uc[tt]); if (FINAL) gt[tt] = bf2f(gn[tt]); }
        { const int sn = (st < 7) ? st + 1 : 7;
#pragma unroll
          for (int tt = 0; tt < 16; ++tt) { un[tt] = up[(size_t)(sn * 16 + tt) * NA]; if (FINAL) gn[tt] = up[(size_t)(sn * 16 + tt) * NA + 512]; } }
        __syncthreads();
        { const bf16x8 a0 = *(const LAS bf16x8*)(UC + (lane & 15) * 520 + wid * 64 + 8 * (lane >> 4)), a1 = *(const LAS bf16x8*)(UC + (lane & 15) * 520 + wid * 64 + 32 + 8 * (lane >> 4));
#pragma unroll
          for (int j = 0; j < 4; ++j) {
            f32x4 r = {0.f, 0.f, 0.f, 0.f}, g = {0.f, 0.f, 0.f, 0.f};
            r = __builtin_amdgcn_mfma_f32_16x16x32_bf16(a0, br[j][0], r, 0, 0, 0); r = __builtin_amdgcn_mfma_f32_16x16x32_bf16(a1, br[j][1], r, 0, 0, 0);
            g = __builtin_amdgcn_mfma_f32_16x16x32_bf16(a0, bi[j][0], g, 0, 0, 0); g = __builtin_amdgcn_mfma_f32_16x16x32_bf16(a1, bi[j][1], g, 0, 0, 0);
#pragma unroll
            for (int i = 0; i < 4; ++i) { const int tok = (lane >> 4) * 4 + i; const float rr = sigmoid_f(r[i] + cbr[j]), ii = sigmoid_f(g[i] + cbi[j]);
                const float a = __builtin_amdgcn_exp2f(-rr * csp[j]); const float bb = sqrtf(fmaxf(1.0f - a * a, 0.f)) * ii;
                const int o = tok * 512 + wid * 64 + 16 * j + (lane & 15); Aa[o] = a; Bb[o] = bb; }
          } }
        __syncthreads();
#pragma unroll
        for (int tt = 0; tt < 16; ++tt) { const float a = Aa[tt * 512 + ch], bb = Bb[tt * 512 + ch]; h = a * h + bb * uc[tt];
            if (FINAL) { const size_t t = t0 + st * 16 + tt; cat[t * DM + ch] = f2bf(h * gt[tt]); } else { P *= a; } }
    }
    if (!FINAL) { ((float*)(ws + WS_AP))[((size_t)b * 32 + ck) * 512 + ch] = P; ((float*)(ws + WS_HE))[((size_t)b * 32 + ck) * 512 + ch] = h; }
    __syncthreads();
}

__device__ __forceinline__ void memkv_item(const Ctx& C, int item) {
    PHASE_IDS();
    const int l = item >> 7, b = (item >> 4) & 7, h = (item >> 2) & 3, mg = item & 3;
    const bf16* kvraw = (const bf16*)(ws + WS_KVRAW);
    const float* kg = par + PKG + l * 128;
    const float c2m = LOG2E * 0.08838834764831845f;
    const float g0 = kg[2 * lane] * c2m, g1 = kg[2 * lane + 1] * c2m;
    const size_t hb = (((size_t)l * 8 + b) * 4 + h);
    bf16* kn = (bf16*)(ws + WS_KN) + hb * 256 * 128;
#pragma unroll
    for (int rr = 0; rr < 8; ++rr) { const int m = mg * 64 + wid * 8 + rr;
        const unsigned kv2 = *(const unsigned*)(kvraw + (size_t)(b * 256 + m) * 2048 + l * 1024 + h * 128 + 2 * lane);
        const float k0 = __uint_as_float(kv2 << 16), k1 = __uint_as_float(kv2 & 0xffff0000u);
        const float ss = wave_sum(k0 * k0 + k1 * k1); const float rinv = 1.0f / sqrtf(ss * (1.0f / 128.0f) + EPS);
        *(unsigned*)(kn + (size_t)m * 128 + 2 * lane) = pk2(k0 * rinv * g0, k1 * rinv * g1); }
    { const int d = tid & 127, mq = tid >> 7; unsigned w[8];
      const bf16* vp = kvraw + (size_t)(b * 256 + mg * 64 + mq * 16) * 2048 + l * 1024 + 512 + h * 128 + d;
#pragma unroll
      for (int p = 0; p < 16; p += 2) { const unsigned lo = vp[(size_t)kperm(p) * 2048], hi = vp[(size_t)kperm(p + 1) * 2048]; w[p >> 1] = lo | (hi << 16); }
      bf16* vt = (bf16*)(ws + WS_VT) + (hb * 128 + d) * 256 + mg * 64 + mq * 16;
      *(u32x4*)vt = (u32x4){w[0], w[1], w[2], w[3]}; *(u32x4*)(vt + 8) = (u32x4){w[4], w[5], w[6], w[7]}; }
}

__device__ __forceinline__ void memattn_unit(const Ctx& C, LAS unsigned char* lds, int l, int unit, const bf16* xq, int ldq) {
    PHASE_IDS();
    const int b = unit >> 5, h = (unit >> 3) & 3, tg = unit & 7, r32 = lane & 31, hi = lane >> 5;
    LAS bf16* Ks = (LAS bf16*)lds;
    LAS bf16* Vs = (LAS bf16*)(lds + 69632);
    LAS float* wsf = (LAS float*)(lds + 137216) + wid * 32;
    const size_t hb = (((size_t)l * 8 + b) * 4 + h);
    const bf16* kn = (const bf16*)(ws + WS_KN) + hb * 256 * 128; const bf16* vt = (const bf16*)(ws + WS_VT) + hb * 128 * 256;
#pragma unroll
    for (int i = 0; i < 8; ++i) { const int idx = tid + 512 * i; const int row = idx >> 4, c = idx & 15; *(LAS u32x4*)(Ks + row * 136 + c * 8) = *(const u32x4*)(kn + row * 128 + c * 8); }
#pragma unroll
    for (int i = 0; i < 8; ++i) { const int idx = tid + 512 * i; const int row = idx >> 5, c = idx & 31; *(LAS u32x4*)(Vs + row * 264 + c * 8) = *(const u32x4*)(vt + row * 256 + c * 8); }
    const float* qg = par + PQG + l * 128; const float* kg = par + PKG + l * 128;
    const float gq = wave_max(fmaxf(fabsf(qg[2 * lane]), fabsf(qg[2 * lane + 1]))), gk = wave_max(fmaxf(fabsf(kg[2 * lane]), fabsf(kg[2 * lane + 1])));
    const float bound = gq * gk * 11.313708498984761f * LOG2E;
    __syncthreads();
    bf16* cat = (bf16*)(ws + WS_CAT);
#pragma unroll 1
    for (int sub = 0; sub < 2; ++sub) {
        const size_t tok0 = (size_t)b * SEQ + tg * 512 + sub * 256 + wid * 32;
        bf16x8 qf[8];
        { const bf16* qp = xq + (tok0 + r32) * ldq + h * 128 + 8 * hi; float ss = 0.f;
#pragma unroll
          for (int ds = 0; ds < 8; ++ds) { qf[ds] = *(const bf16x8*)(qp + 16 * ds);
#pragma unroll
              for (int j = 0; j < 8; ++j) { const float f = bf2f((unsigned short)qf[ds][j]); ss += f * f; } }
          ss += __shfl_xor(ss, 32); const float rinv = 1.0f / sqrtf(ss * (1.0f / 128.0f) + EPS);
#pragma unroll
          for (int ds = 0; ds < 8; ++ds) { const f32x4 ga = *(const f32x4*)(qg + 16 * ds + 8 * hi), gb = *(const f32x4*)(qg + 16 * ds + 8 * hi + 4);
              unsigned w[4];
#pragma unroll
              for (int j = 0; j < 4; ++j) { const float f0 = bf2f((unsigned short)qf[ds][2 * j]) * rinv * (2 * j < 4 ? ga[(2 * j) & 3] : gb[(2 * j) & 3]);
                  const float f1 = bf2f((unsigned short)qf[ds][2 * j + 1]) * rinv * (2 * j + 1 < 4 ? ga[(2 * j + 1) & 3] : gb[(2 * j + 1) & 3]); w[j] = pk2(f0, f1); }
              qf[ds] = __builtin_bit_cast(bf16x8, (u32x4){w[0], w[1], w[2], w[3]}); } }
        f32x16 o[4]; float lsum = 0.f;
#pragma unroll
        for (int db = 0; db < 4; ++db)
#pragma unroll
            for (int r = 0; r < 16; ++r) o[db][r] = 0.f;
#pragma unroll 1
        for (int kb = 0; kb < 8; ++kb) {
            f32x16 p0;
#pragma unroll
            for (int r = 0; r < 16; ++r) p0[r] = -bound;
#pragma unroll
            for (int ds = 0; ds < 8; ++ds) { const bf16x8 k0 = *(const LAS bf16x8*)(Ks + (32 * kb + r32) * 136 + 16 * ds + 8 * hi);
                p0 = __builtin_amdgcn_mfma_f32_32x32x16_bf16(k0, qf[ds], p0, 0, 0, 0); if ((ds & 3) == 3) __builtin_amdgcn_sched_barrier(0); }
#pragma unroll
            for (int r = 0; r < 16; ++r) { p0[r] = __builtin_amdgcn_exp2f(p0[r]); lsum += p0[r]; }
            bf16x8 pa[2];
            pa[0] = __builtin_bit_cast(bf16x8, (u32x4){pk2(p0[0], p0[1]), pk2(p0[2], p0[3]), pk2(p0[4], p0[5]), pk2(p0[6], p0[7])});
            pa[1] = __builtin_bit_cast(bf16x8, (u32x4){pk2(p0[8], p0[9]), pk2(p0[10], p0[11]), pk2(p0[12], p0[13]), pk2(p0[14], p0[15])});
#pragma unroll
            for (int db = 0; db < 4; ++db) {
#pragma unroll
                for (int s = 0; s < 2; ++s) { const bf16x8 v = *(const LAS bf16x8*)(Vs + (32 * db + r32) * 264 + 32 * kb + 16 * s + 8 * hi);
                    o[db] = __builtin_amdgcn_mfma_f32_32x32x16_bf16(pa[s], v, o[db], 0, 0, 0); }
                if (db & 1) __builtin_amdgcn_sched_barrier(0); }
        }
        lsum += __shfl_xor(lsum, 32);
        if (hi == 0) wsf[r32] = lsum;
        asm volatile("s_waitcnt lgkmcnt(0)" ::: "memory");
#pragma unroll
        for (int r = 0; r < 16; ++r) { const float rl = __builtin_amdgcn_rcpf(wsf[crow(r, hi)]); bf16* op = cat + (tok0 + crow(r, hi)) * DM + 512 + h * 128 + r32;
#pragma unroll
            for (int db = 0; db < 4; ++db) op[32 * db] = f2bf(o[db][r] * rl); }
        asm volatile("s_waitcnt lgkmcnt(0)" ::: "memory");
    }
    __syncthreads();
}

__device__ __forceinline__ void foxprep_unit(const Ctx& C, LAS unsigned char* lds, int unit) {
    PHASE_IDS();
    const int b = unit >> 6, ck = unit & 63;
    LAS float* LF = (LAS float*)lds;
    const size_t t0 = (size_t)b * SEQ + (size_t)ck * 64;
    const bf16* proj = (const bf16*)(ws + WS_PROJ);
    if (wid < 4) {
        f32x4 acc = {0.f, 0.f, 0.f, 0.f};
        const bf16* ap = (const bf16*)(ws + WS_XB) + (t0 + 16 * wid + (lane & 15)) * DM + 8 * (lane >> 4);
        const bf16* bp = (const bf16*)(ws + WS_WF) + (size_t)(lane & 15) * DM + 8 * (lane >> 4);
#pragma unroll 4
        for (int ks = 0; ks < 32; ++ks) acc = __builtin_amdgcn_mfma_f32_16x16x32_bf16(*(const bf16x8*)(ap + 32 * ks), *(const bf16x8*)(bp + 32 * ks), acc, 0, 0, 0);
        const int n = lane & 15; const float bfg = par[PBF + n];
#pragma unroll
        for (int i = 0; i < 4; ++i) { const int row = 16 * wid + (lane >> 4) * 4 + i;
            const f32x4* sp = (const f32x4*)((const float*)(ws + WS_SSP) + (t0 + row) * 16); const f32x4 s0 = sp[0], s1 = sp[1], s2 = sp[2], s3 = sp[3];
            const float ss = ((s0[0] + s0[1]) + (s0[2] + s0[3])) + ((s1[0] + s1[1]) + (s1[2] + s1[3])) + ((s2[0] + s2[1]) + (s2[2] + s2[3])) + ((s3[0] + s3[1]) + (s3[2] + s3[3]));
            const float rs = 1.0f / sqrtf(ss * (1.0f / 1024.0f) + EPS);
            const float logit = acc[i] * rs + bfg;
            const float lf = -__builtin_amdgcn_logf(1.0f + __builtin_amdgcn_exp2f(-LOG2E * logit));
            if (n < 8) LF[row * 8 + n] = lf; }
    }
    { const float c2f = 0.125f * LOG2E;
      for (int jb = wid; jb < 128; jb += 8) { const int which = jb >> 6; const size_t tok = t0 + (jb & 63);
        const bf16x8 v = *(const bf16x8*)(proj + tok * NQ + which * 512 + 8 * lane); float f[8]; float ss = 0.f;
#pragma unroll
        for (int j = 0; j < 8; ++j) { f[j] = bf2f((unsigned short)v[j]); ss += f[j] * f[j]; }
        ss += __shfl_xor(ss, 1); ss += __shfl_xor(ss, 2); ss += __shfl_xor(ss, 4);
        const float rinv = (1.0f / sqrtf(ss * (1.0f / 64.0f) + EPS)) * (which ? 1.0f : c2f);
        const float* gp = par + (which ? PFKG : PFQG) + ((8 * lane) & 63); const f32x4 ga = *(const f32x4*)gp, gb = *(const f32x4*)(gp + 4);
        u32x4 w; w.x = pk2(f[0] * rinv * ga[0], f[1] * rinv * ga[1]); w.y = pk2(f[2] * rinv * ga[2], f[3] * rinv * ga[3]); w.z = pk2(f[4] * rinv * gb[0], f[5] * rinv * gb[1]); w.w = pk2(f[6] * rinv * gb[2], f[7] * rinv * gb[3]);
        *(u32x4*)((bf16*)(ws + (which ? WS_KNF : WS_QN)) + tok * 512 + 8 * lane) = w; } }
    { const int hd = tid; bf16* vtf = (bf16*)(ws + WS_VTF) + (((size_t)b * 8 + (hd >> 6)) * 64 + (hd & 63)) * SEQ + (size_t)ck * 64;
      for (int g = 0; g < 4; ++g) { unsigned w[8]; const bf16* vp = proj + (t0 + 16 * g) * NQ + 1024 + hd;
#pragma unroll
        for (int p = 0; p < 16; p += 2) { const unsigned lo = vp[(size_t)kperm(p) * NQ], hi = vp[(size_t)kperm(p + 1) * NQ]; w[p >> 1] = lo | (hi << 16); }
        *(u32x4*)(vtf + 16 * g) = (u32x4){w[0], w[1], w[2], w[3]}; *(u32x4*)(vtf + 16 * g + 8) = (u32x4){w[4], w[5], w[6], w[7]}; } }
    __syncthreads();
    if (tid < 8) { float c = 0.f; float* cl = (float*)(ws + WS_CL) + ((size_t)b * 8 + tid) * SEQ + (size_t)ck * 64;
        for (int row = 0; row < 64; ++row) { c += LF[row * 8 + tid]; cl[row] = c; }
        ((float*)(ws + WS_CTOT))[((size_t)b * 8 + tid) * 64 + ck] = c; }
    __syncthreads();
}

__device__ __forceinline__ void fox_unit(const Ctx& C, LAS unsigned char* lds, int b, int h, int qb) {
    PHASE_IDS();
    const int r32 = lane & 31, hi = lane >> 5;
    LAS bf16* Ks = (LAS bf16*)lds;
    LAS bf16* Vs = (LAS bf16*)(lds + 9216);
    LAS float* CJ = (LAS float*)(lds + 18432);
    LAS float* COF = (LAS float*)(lds + 18688);
    LAS float* wsf = (LAS float*)(lds + 18944) + wid * 32;
    const size_t bh = (size_t)b * 8 + h;
    const float* cl = (const float*)(ws + WS_CL) + bh * SEQ;
    if (wid == 0) { const float own = ((const float*)(ws + WS_CTOT))[bh * 64 + lane]; float v = own;
#pragma unroll
        for (int o = 1; o < 64; o <<= 1) { const float t = __shfl_up(v, o); if (lane >= o) v += t; }
        COF[lane] = v - own; }
    const float* qg = par + PFQG; const float* kg = par + PFKG;
    const float gq = wave_max(fabsf(qg[lane])), gk = wave_max(fabsf(kg[lane]));
    const float bound = 8.0f * gq * gk * LOG2E;
    __syncthreads();
    const float base = COF[4 * qb];
    const int q0 = 256 * qb, qw0 = q0 + 32 * wid, qrow = qw0 + r32;
    const float ci = cl[qrow] + (COF[qrow >> 6] - base) - bound;
    bf16x8 qf[4];
    { const bf16* qp = (const bf16*)(ws + WS_QN) + ((size_t)b * SEQ + qrow) * 512 + h * 64 + 8 * hi;
#pragma unroll
      for (int ds = 0; ds < 4; ++ds) qf[ds] = *(const bf16x8*)(qp + 16 * ds); }
    const int NT = 4 * (qb + 1);
    const bf16* kp = (const bf16*)(ws + WS_KNF) + ((size_t)b * SEQ + (tid >> 3)) * 512 + h * 64 + (tid & 7) * 8;
    const bf16* vp = (const bf16*)(ws + WS_VTF) + (bh * 64 + (tid >> 3)) * SEQ + (tid & 7) * 8;
    u32x4 kreg = *(const u32x4*)kp, vreg = *(const u32x4*)vp; float cjreg = (tid < 64) ? cl[tid] : 0.f;
    f32x16 o[2]; float lsum = 0.f;
#pragma unroll
    for (int r = 0; r < 16; ++r) { o[0][r] = 0.f; o[1][r] = 0.f; }
    for (int j = 0; j < NT; ++j) {
        __syncthreads();
        *(LAS u32x4*)(Ks + (tid >> 3) * 72 + (tid & 7) * 8) = kreg; *(LAS u32x4*)(Vs + (tid >> 3) * 72 + (tid & 7) * 8) = vreg;
        if (tid < 64) CJ[tid] = cjreg + (COF[j] - base);
        __syncthreads();
        if (j + 1 < NT) { kreg = *(const u32x4*)(kp + (size_t)(j + 1) * 64 * 512); vreg = *(const u32x4*)(vp + (j + 1) * 64); if (tid < 64) cjreg = cl[(j + 1) * 64 + tid]; }
        if (64 * j <= qw0 + 31) {
            f32x16 p0, p1;
#pragma unroll
            for (int g = 0; g < 4; ++g) { const f32x4 c0 = *(const LAS f32x4*)(CJ + 8 * g + 4 * hi), c1 = *(const LAS f32x4*)(CJ + 32 + 8 * g + 4 * hi);
#pragma unroll
                for (int e = 0; e < 4; ++e) { p0[4 * g + e] = ci - c0[e]; p1[4 * g + e] = ci - c1[e]; } }
            if (64 * j + 63 > qw0) {
#pragma unroll
                for (int r = 0; r < 16; ++r) { const int kv = 64 * j + crow(r, hi); if (kv > qrow) p0[r] = -INFINITY; if (kv + 32 > qrow) p1[r] = -INFINITY; } }
#pragma unroll
            for (int ds = 0; ds < 4; ++ds) { const bf16x8 k0 = *(const LAS bf16x8*)(Ks + r32 * 72 + 16 * ds + 8 * hi), k1 = *(const LAS bf16x8*)(Ks + (32 + r32) * 72 + 16 * ds + 8 * hi);
                p0 = __builtin_amdgcn_mfma_f32_32x32x16_bf16(k0, qf[ds], p0, 0, 0, 0); p1 = __builtin_amdgcn_mfma_f32_32x32x16_bf16(k1, qf[ds], p1, 0, 0, 0); }
#pragma unroll
            for (int r = 0; r < 16; ++r) { p0[r] = __builtin_amdgcn_exp2f(p0[r]); p1[r] = __builtin_amdgcn_exp2f(p1[r]); lsum += p0[r] + p1[r]; }
            bf16x8 pa[4];
            pa[0] = __builtin_bit_cast(bf16x8, (u32x4){pk2(p0[0], p0[1]), pk2(p0[2], p0[3]), pk2(p0[4], p0[5]), pk2(p0[6], p0[7])});
            pa[1] = __builtin_bit_cast(bf16x8, (u32x4){pk2(p0[8], p0[9]), pk2(p0[10], p0[11]), pk2(p0[12], p0[13]), pk2(p0[14], p0[15])});
            pa[2] = __builtin_bit_cast(bf16x8, (u32x4){pk2(p1[0], p1[1]), pk2(p1[2], p1[3]), pk2(p1[4], p1[5]), pk2(p1[6], p1[7])});
            pa[3] = __builtin_bit_cast(bf16x8, (u32x4){pk2(p1[8], p1[9]), pk2(p1[10], p1[11]), pk2(p1[12], p1[13]), pk2(p1[14], p1[15])});
#pragma unroll
            for (int db = 0; db < 2; ++db)
#pragma unroll
                for (int s = 0; s < 4; ++s) { const bf16x8 v = *(const LAS bf16x8*)(Vs + (32 * db + r32) * 72 + 16 * s + 8 * hi);
                    o[db] = __builtin_amdgcn_mfma_f32_32x32x16_bf16(pa[s], v, o[db], 0, 0, 0); }
        }
    }
    lsum += __shfl_xor(lsum, 32);
    if (hi == 0) wsf[r32] = lsum;
    asm volatile("s_waitcnt lgkmcnt(0)" ::: "memory");
    bf16* cat = (bf16*)(ws + WS_CAT);
#pragma unroll
    for (int r = 0; r < 16; ++r) { const float rl = __builtin_amdgcn_rcpf(wsf[crow(r, hi)]); bf16* op = cat + ((size_t)b * SEQ + qw0 + crow(r, hi)) * DM + h * 64 + r32;
        op[0] = f2bf(o[0][r] * rl); op[32] = f2bf(o[1][r] * rl); }
    __syncthreads();
}

constexpr int NPHASE = 13;
__global__ void __launch_bounds__(NWAVES * 64, 2) fwd_kernel(Args args) {
    extern __shared__ __attribute__((aligned(16))) unsigned char lds_raw[];
    LAS unsigned char* lds = (LAS unsigned char*)lds_raw;
    Ctx C;
    C.x = args.in[0]; C.out = args.out; C.ws = args.ws;
    C.G = gridDim.x; { const int bx = blockIdx.x; C.vcu = (C.G % 8 == 0) ? (bx % 8) * (C.G / 8) + bx / 8 : bx; }
    unsigned char* ws = args.ws;
    const int lo = args.ph_lo, hi = args.ph_hi;
#ifndef PROBE_SUB
#define PROBE_SUB 0
#endif
#ifndef PHASE_MASK
#define PHASE_MASK 0x1fff
#endif
#define IN(k) (((PHASE_MASK >> (k)) & 1) && lo <= (k) && (k) < hi)
#define SEAM(k) do { if (IN(k) && IN((k) + 1)) { cg::this_grid().sync(); } } while (0)
    bf16* XB = (bf16*)(ws + WS_XB); float* SSP = (float*)(ws + WS_SSP); bf16* PROJ = (bf16*)(ws + WS_PROJ); bf16* CAT = (bf16*)(ws + WS_CAT); bf16* HB = (bf16*)(ws + WS_H);

    if (IN(0)) { p0_prologue(args, C, lds); } SEAM(0);
    if (IN(1)) {
        { pg8::Gemm g{(const bf16*)(ws + WS_MEMB), (const bf16*)(ws + WS_WKV), MROWS, 2048, DM}; pg8::StaticOrder S; S.init(MROWS, 2048, C.G, (int)blockIdx.x);
          pg8::EpiAct<0> E{(bf16*)(ws + WS_KVRAW), 2048, (const float*)(ws + WS_MEMSS), 1.0f / DM, EPS};
          pg8::gemm_phase<pg8::EpiAct<0>, pg8::StaticOrder, PG8_ALIGN, PG8_SP2>(lds, g, S, E); }
        { pg8::Gemm g{XB, (const bf16*)(ws + WS_WA), T, NA, DM}; pg8::StaticOrder S; S.init(T, NA, C.G, (int)blockIdx.x);
          pg8::EpiAct<1> E{PROJ, NA, SSP, 1.0f / DM, EPS};
          pg8::gemm_phase<pg8::EpiAct<1>, pg8::StaticOrder, PG8_ALIGN, PG8_SP2>(lds, g, S, E); }
    } SEAM(1);
    if (IN(2)) {
        for (int rr = 0; rr < (PROBE_SUB == 3 ? 2 : 1); ++rr)
        for (int u = C.vcu; u < 256; u += C.G) memkv_item(C, u);
        for (int u = C.vcu; u < 256; u += C.G) lru_unit<false>(C, lds, u >> 5, u & 31);
    } SEAM(2);
    if (IN(3)) {
        for (int rr = 0; rr < (PROBE_SUB == 1 ? 2 : 1); ++rr)
        for (int u = C.vcu; u < 256; u += C.G) lru_unit<true>(C, lds, u >> 5, u & 31);
        for (int u = C.vcu; u < 256; u += C.G) memattn_unit(C, lds, 0, u, PROJ + 1024, NA);
    } SEAM(3);
    if (IN(4)) { pg8::Gemm g{CAT, (const bf16*)(ws + WS_WO), T, DM, DM}; pg8::StaticOrder S; S.init(T, DM, C.G, (int)blockIdx.x);
        pg8::EpiResB<true, false> E{C.x, XB, SSP, C.out, DM};
        pg8::gemm_phase<pg8::EpiResB<true, false>, pg8::StaticOrder, PG8_ALIGN, PG8_SP2>(lds, g, S, E); } SEAM(4);
    if (IN(5)) { pg8::Gemm g{XB, (const bf16*)(ws + WS_W1), T, FF, DM}; pg8::StaticOrder S; S.init(T, FF, C.G, (int)blockIdx.x);
        pg8::EpiAct<2> E{HB, FF, SSP, 1.0f / DM, EPS};
        pg8::gemm_phase<pg8::EpiAct<2>, pg8::StaticOrder, PG8_ALIGN, PG8_SP2>(lds, g, S, E); } SEAM(5);
    if (IN(6)) { pg8::Gemm g{HB, (const bf16*)(ws + WS_W2), T, DM, FF}; pg8::StaticOrder S; S.init(T, DM, C.G, (int)blockIdx.x);
        pg8::EpiResB<false, false> E{nullptr, XB, SSP, C.out, DM};
        pg8::gemm_phase<pg8::EpiResB<false, false>, pg8::StaticOrder, PG8_ALIGN, PG8_SP2>(lds, g, S, E); } SEAM(6);
    if (IN(7)) { pg8::Gemm g{XB, (const bf16*)(ws + WS_WB), T, NQ, DM}; pg8::StaticOrder S; S.init(T, NQ, C.G, (int)blockIdx.x);
        pg8::EpiAct<0> E{PROJ, NQ, SSP, 1.0f / DM, EPS};
        pg8::gemm_phase<pg8::EpiAct<0>, pg8::StaticOrder, PG8_ALIGN, PG8_SP2>(lds, g, S, E); } SEAM(7);
    if (IN(8)) {
        for (int rr = 0; rr < (PROBE_SUB == 2 ? 2 : 1); ++rr)
        for (int u = C.vcu; u < 512; u += C.G) foxprep_unit(C, lds, u);
        for (int u = C.vcu; u < 256; u += C.G) memattn_unit(C, lds, 1, u, PROJ + 1536, NQ);
    } SEAM(8);
    if (IN(9)) {
        for (int u = C.vcu; u < 1024; u += C.G) { const int i = u / C.G, v = u % C.G; int bh, qb;
            if (C.G == 256) { const int s = v & 3; bh = v >> 2; qb = (i == 0) ? s : (i == 1) ? 7 - s : (i == 2) ? 8 + s : 15 - s; } else { bh = u >> 4; qb = u & 15; }
            fox_unit(C, lds, bh >> 3, bh & 7, qb); }
    } SEAM(9);
    if (IN(10)) { pg8::Gemm g{CAT, (const bf16*)(ws + WS_WO) + (size_t)DM * DM, T, DM, DM}; pg8::StaticOrder S; S.init(T, DM, C.G, (int)blockIdx.x);
        pg8::EpiResB<false, false> E{nullptr, XB, SSP, C.out, DM};
        pg8::gemm_phase<pg8::EpiResB<false, false>, pg8::StaticOrder, PG8_ALIGN, PG8_SP2>(lds, g, S, E); } SEAM(10);
    if (IN(11)) { pg8::Gemm g{XB, (const bf16*)(ws + WS_W1) + (size_t)DM * FF, T, FF, DM}; pg8::StaticOrder S; S.init(T, FF, C.G, (int)blockIdx.x);
        pg8::EpiAct<2> E{HB, FF, SSP, 1.0f / DM, EPS};
        pg8::gemm_phase<pg8::EpiAct<2>, pg8::StaticOrder, PG8_ALIGN, PG8_SP2>(lds, g, S, E); } SEAM(11);
    if (IN(12)) { pg8::Gemm g{HB, (const bf16*)(ws + WS_W2) + (size_t)DM * FF, T, DM, FF}; pg8::StaticOrder S; S.init(T, DM, C.G, (int)blockIdx.x);
        pg8::EpiResB<false, true> E{nullptr, XB, SSP, C.out, DM};
        pg8::gemm_phase<pg8::EpiResB<false, true>, pg8::StaticOrder, PG8_ALIGN, PG8_SP2>(lds, g, S, E); }
#undef IN
#undef SEAM
}

extern "C" void kernel_launch(void* const* d_in, const int* in_sizes, int n_in, void* d_out, int out_size, void* d_ws, size_t ws_size, hipStream_t stream) {
    static int grid = 0;
    if (grid == 0) {
        if (n_in != 23 || in_sizes[0] != T * DM || out_size != T * DM || ws_size < WS_END) { fprintf(stderr, "kernel_launch: unexpected shapes (n_in %d, in0 %d, out %d, ws %zu)\n", n_in, n_in > 0 ? in_sizes[0] : -1, out_size, ws_size); grid = -1; return; }
        int dev = 0, cus = 0, per_cu = 0;
        if (hipGetDevice(&dev) != hipSuccess || hipDeviceGetAttribute(&cus, hipDeviceAttributeMultiprocessorCount, dev) != hipSuccess) { grid = -1; return; }
        if (hipFuncSetAttribute((const void*)fwd_kernel, hipFuncAttributeMaxDynamicSharedMemorySize, LDS_BYTES) != hipSuccess) { fprintf(stderr, "kernel_launch: hipFuncSetAttribute failed\n"); grid = -1; return; }
        if (hipOccupancyMaxActiveBlocksPerMultiprocessor(&per_cu, (const void*)fwd_kernel, NWAVES * 64, LDS_BYTES) != hipSuccess || per_cu < 1) { fprintf(stderr, "kernel_launch: occupancy query says %d\n", per_cu); per_cu = 1; }
        (void)hipGetLastError();
        grid = cus;
    }
    if (grid < 0) return;
    Args a{};
    for (int i = 0; i < 23; ++i) a.in[i] = (const float*)d_in[i];
    a.out = (float*)d_out; a.ws = (unsigned char*)d_ws;
#if MK_MULTI
#ifndef REP_MASK
#define REP_MASK 0
#endif
    for (int p = 0; p < NPHASE; ++p) { a.ph_lo = p; a.ph_hi = p + 1; const int reps = ((REP_MASK >> p) & 1) ? 2 : 1;
        for (int r = 0; r < reps; ++r) hipLaunchKernelGGL(fwd_kernel, dim3(grid), dim3(NWAVES * 64), LDS_BYTES, stream, a); }
#else
    a.ph_lo = 0; a.ph_hi = NPHASE;
    void* kargs[] = {&a};
    hipError_t e = hipLaunchCooperativeKernel((const void*)fwd_kernel, dim3(grid), dim3(NWAVES * 64), kargs, LDS_BYTES, stream);
    if (e != hipSuccess) fprintf(stderr, "kernel_launch: cooperative launch failed: %s (grid %d)\n", hipGetErrorString(e), grid);
#endif
}
```

```cpp
#include <hip/hip_runtime.h>
#include <hip/hip_cooperative_groups.h>
#include <cstdio>
#include <cstdint>
namespace cg = cooperative_groups;
#ifndef MK_MULTI
#define MK_MULTI 0
#endif
namespace pg8 {
#define PG8_LAS __attribute__((address_space(3)))
typedef unsigned short bf16_t;
typedef short bf16x8 __attribute__((ext_vector_type(8)));
typedef float f32x4 __attribute__((ext_vector_type(4)));
typedef unsigned u32x4 __attribute__((ext_vector_type(4)));
constexpr int BM = 256, BK = 64, HALF = 128, HTB = HALF * BK * 2  , STAGE_BYTES = 8 * HTB, NXCD = 8, WGM = 8;

__host__ __device__ __forceinline__ int lds_byte(int r, int c) { const int st = (r >> 4) * 2 + (c >> 5), rr = r & 15, cc = c & 31, ob = rr * 64 + cc * 2; return st * 1024 + (ob ^ (((ob >> 9) & 1) << 5)); }
__host__ __device__ __forceinline__ void stage_rc(int b, int& R, int& C) { const int st = b / 1024, sb = b % 1024, swz = sb ^ (((sb >> 9) & 1) << 5); R = (st >> 1) * 16 + swz / 64; C = (st & 1) * 32 + (swz % 64) / 2; }
__host__ __device__ __forceinline__ int perm32(int rho) { const int n = rho >> 4, i = rho & 15; return 8 * (i >> 2) + 4 * n + (i & 3); }

struct Unit { int pm, pn; };
struct Gemm { const bf16_t* A; const bf16_t* Bt; int M, N, K; };

struct StaticOrder {
    int nM, nN, nwg, G, c;
    __host__ __device__ void init(int M, int N, int G_, int c_) { nM = M / BM; nN = N / BM; nwg = nM * nN; G = G_; c = c_; }
    __host__ __device__ bool next(int i, Unit& u) const {
        const long L = (long)i * G + c; if (L >= nwg) return false;
        int wgid = (int)L; { const int q = nwg / NXCD, r = nwg % NXCD, xcd = wgid % NXCD, off = wgid / NXCD; wgid = (xcd < r ? xcd * (q + 1) : r * (q + 1) + (xcd - r) * q) + off; }
        const int nig = WGM * nN, gid = wgid / nig, fm = gid * WGM, gsz = (nM - fm) < WGM ? (nM - fm) : WGM;
        u.pm = fm + ((wgid % nig) % gsz); u.pn = (wgid % nig) / gsz; return true;
    }
    __device__ __forceinline__ void a_ready(const Unit&) const {}
    __device__ __forceinline__ void done(const Unit&) const {}
};

__device__ __forceinline__ unsigned cvt_pk_bf16(float lo, float hi) { unsigned r; asm volatile("v_cvt_pk_bf16_f32 %0, %1, %2" : "=v"(r) : "v"(lo), "v"(hi)); return r; }
typedef float f32x2 __attribute__((ext_vector_type(2)));
typedef float f32x2 __attribute__((ext_vector_type(2)));
typedef unsigned u32x2 __attribute__((ext_vector_type(2)));
__device__ __forceinline__ float gelu_tanh_f(float x) {
    const float z = 0.7978845608028654f * (x + 0.044715f * x * x * x);
    const float e = __builtin_amdgcn_exp2f(-2.0f * 1.4426950408889634f * z);
    return x * __builtin_amdgcn_rcpf(1.0f + e);
}
template <int ACT  > struct EpiAct {
    static constexpr bool PERM = true, AFTER_DRAIN = false;
    bf16_t* O; int ldc; const float* ssp; float inv_n; float eps;
    __device__ __forceinline__ void operator()(const f32x4 (&acc)[2][2][4][2], const Unit& u, int wr, int wc, int fr, int fq) const {
        const int row0 = u.pm * BM + wr * 64 + fr, col0 = u.pn * BM + wc * 32 + 8 * fq;
        const bool gel = (ACT == 1) && (u.pn >= 2) && (u.pn < 4);
#pragma unroll
        for (int ai = 0; ai < 2; ++ai)
#pragma unroll
            for (int m = 0; m < 4; ++m) {
                const int row = row0 + ai * HALF + m * 16;
                const f32x4* sp = (const f32x4*)(ssp + (size_t)row * 16);
                const f32x4 s0 = sp[0], s1 = sp[1], s2 = sp[2], s3 = sp[3];
                const float ss = ((s0[0] + s0[1]) + (s0[2] + s0[3])) + ((s1[0] + s1[1]) + (s1[2] + s1[3])) + ((s2[0] + s2[1]) + (s2[2] + s2[3])) + ((s3[0] + s3[1]) + (s3[2] + s3[3]));
                const float rs = 1.0f / sqrtf(ss * inv_n + eps);
                bf16_t* rowp = O + (size_t)row * ldc + col0;
#pragma unroll
                for (int bj = 0; bj < 2; ++bj) {
                    f32x4 v0 = acc[ai][bj][m][0] * rs, v1 = acc[ai][bj][m][1] * rs;
                    if (ACT == 1) { if (gel) {
#pragma unroll
                        for (int e = 0; e < 4; ++e) { v0[e] = gelu_tanh_f(v0[e]); v1[e] = gelu_tanh_f(v1[e]); } } }
                    if (ACT == 2) {
#pragma unroll
                        for (int e = 0; e < 4; ++e) { const float a = fmaxf(v0[e], 0.f), b = fmaxf(v1[e], 0.f); v0[e] = a * a; v1[e] = b * b; } }
                    u32x4 w; w.x = cvt_pk_bf16(v0[0], v0[1]); w.y = cvt_pk_bf16(v0[2], v0[3]); w.z = cvt_pk_bf16(v1[0], v1[1]); w.w = cvt_pk_bf16(v1[2], v1[3]);
                    *(u32x4*)(rowp + bj * HALF) = w; }
            }
    }
};
template <bool BASE_F32, bool LAST> struct EpiResB {
    static constexpr bool PERM = true, AFTER_DRAIN = false;
    const float* basef; bf16_t* xb; float* ssp; float* out; int ldc;
    __device__ __forceinline__ void operator()(const f32x4 (&acc)[2][2][4][2], const Unit& u, int wr, int wc, int fr, int fq) const {
        const int row0 = u.pm * BM + wr * 64 + fr, col0 = u.pn * BM + wc * 32 + 8 * fq;
#pragma unroll
        for (int ai = 0; ai < 2; ++ai) {
            f32x4 pf[BASE_F32 ? 4 : 1][2][2]; u32x4 pb[BASE_F32 ? 1 : 4][2];
#pragma unroll
            for (int m = 0; m < 4; ++m) { const size_t off = (size_t)(row0 + ai * HALF + m * 16) * ldc + col0;
#pragma unroll
                for (int bj = 0; bj < 2; ++bj) {
                    if (BASE_F32) { pf[BASE_F32 ? m : 0][bj][0] = *(const f32x4*)(basef + off + bj * HALF); pf[BASE_F32 ? m : 0][bj][1] = *(const f32x4*)(basef + off + bj * HALF + 4); }
                    else pb[BASE_F32 ? 0 : m][bj] = *(const u32x4*)(xb + off + bj * HALF); } }
            asm volatile("" ::: "memory");
#pragma unroll
            for (int m = 0; m < 4; ++m) {
                const int row = row0 + ai * HALF + m * 16; const size_t off = (size_t)row * ldc + col0; float ss = 0.f;
#pragma unroll
                for (int bj = 0; bj < 2; ++bj) {
                    f32x4 b0, b1;
                    if (BASE_F32) { b0 = pf[BASE_F32 ? m : 0][bj][0]; b1 = pf[BASE_F32 ? m : 0][bj][1]; }
                    else { const u32x4 w = pb[BASE_F32 ? 0 : m][bj];
                        b0 = (f32x4){__uint_as_float(w.x << 16), __uint_as_float(w.x & 0xffff0000u), __uint_as_float(w.y << 16), __uint_as_float(w.y & 0xffff0000u)};
                        b1 = (f32x4){__uint_as_float(w.z << 16), __uint_as_float(w.z & 0xffff0000u), __uint_as_float(w.w << 16), __uint_as_float(w.w & 0xffff0000u)}; }
                    const f32x4 v0 = b0 + acc[ai][bj][m][0], v1 = b1 + acc[ai][bj][m][1];
                    if (LAST) { *(f32x4*)(out + off + bj * HALF) = v0; *(f32x4*)(out + off + bj * HALF + 4) = v1; }
                    else { ss += ((v0[0] * v0[0] + v0[1] * v0[1]) + (v0[2] * v0[2] + v0[3] * v0[3])) + ((v1[0] * v1[0] + v1[1] * v1[1]) + (v1[2] * v1[2] + v1[3] * v1[3]));
                        u32x4 w; w.x = cvt_pk_bf16(v0[0], v0[1]); w.y = cvt_pk_bf16(v0[2], v0[3]); w.z = cvt_pk_bf16(v1[0], v1[1]); w.w = cvt_pk_bf16(v1[2], v1[3]);
                        *(u32x4*)(xb + off + bj * HALF) = w; } }
                if (!LAST) { ss += __shfl_xor(ss, 16); ss += __shfl_xor(ss, 32); if (fq == 0) ssp[(size_t)row * 16 + u.pn * 4 + wc] = ss; }
            }
            asm volatile("" ::: "memory");
        }
    }
};
template <class Epi, class Sched, bool ALIGN_EPI = false, bool SP2 = false>
__device__ __forceinline__ void gemm_phase(PG8_LAS unsigned char* lds, const Gemm g, const Sched& S, const Epi& E) {
    const int tid = threadIdx.x, wid = __builtin_amdgcn_readfirstlane(tid >> 6), lane = tid & 63, wr = wid >> 2, wc = wid & 3, fr = lane & 15, fq = lane >> 4;
    const int K = g.K, nt = K / BK;
    unsigned voffA[2], voffB[2];
#pragma unroll
    for (int i = 0; i < 2; ++i) { int R, C; stage_rc(tid * 16 + i * 8192, R, C); const int Rb = Epi::PERM ? ((R & ~31) + perm32(R & 31)) : R;
        voffA[i] = (unsigned)(R * K + C) * 2u; voffB[i] = (unsigned)(Rb * K + C) * 2u; }
    const size_t kstep = (size_t)(BK * 2);
    const size_t hstep = (size_t)HALF * K * 2;
    const size_t tstep = 2 * hstep;
    const unsigned ldsw = (unsigned)wid * 1024u;
    const int aoff = lds_byte(wr * 64 + fr, fq * 8), boff = lds_byte(wc * 32 + fr, fq * 8);
#define PG8_SA(b, h) (((b) * 2 + (h)) * HTB)
#define PG8_SB(b, h) ((4 + (b) * 2 + (h)) * HTB)
#define PG8_STAGE(bufoff, gbase, voff) do { _Pragma("unroll") for (int _i = 0; _i < 2; ++_i) \
        __builtin_amdgcn_global_load_lds((const unsigned*)((const char*)(gbase) + (voff)[_i]), (PG8_LAS unsigned*)(lds + (bufoff) + ldsw + _i * 8192), 16, 0, 0); } while (0)
#define PG8_LDA(dst, b, h) do { _Pragma("unroll") for (int m = 0; m < 4; ++m) _Pragma("unroll") for (int k = 0; k < 2; ++k) dst[m][k] = *(const PG8_LAS bf16x8*)(lds + PG8_SA(b, h) + aoff + m * 2048 + k * 1024); } while (0)
#define PG8_LDB(dst, b, h) do { _Pragma("unroll") for (int n = 0; n < 2; ++n) _Pragma("unroll") for (int k = 0; k < 2; ++k) dst[n][k] = *(const PG8_LAS bf16x8*)(lds + PG8_SB(b, h) + boff + n * 2048 + k * 1024); } while (0)
#define PG8_MMA(ai, bj, At, Bt) do { __builtin_amdgcn_s_setprio(1); _Pragma("unroll") for (int m = 0; m < 4; ++m) _Pragma("unroll") for (int n = 0; n < 2; ++n) _Pragma("unroll") for (int k = 0; k < 2; ++k) \
        acc[ai][bj][m][n] = __builtin_amdgcn_mfma_f32_16x16x32_bf16(Bt[n][k], At[m][k], acc[ai][bj][m][n], 0, 0, 0); __builtin_amdgcn_s_setprio(0); } while (0)
#define PG8_WAIT_V(n) asm volatile("s_waitcnt vmcnt(" #n ")" ::: "memory")
#define PG8_WAIT_L(n) asm volatile("s_waitcnt lgkmcnt(" #n ")" ::: "memory")
#define PG8_BAR __builtin_amdgcn_s_barrier()
#define PG8_SCHED __builtin_amdgcn_sched_barrier(0)
    Unit cur, nxt; int ui = 0;
    if (!S.next(0, cur)) return;
    f32x4 acc[2][2][4][2];
#pragma unroll
    for (int a = 0; a < 2; ++a)
#pragma unroll
        for (int b = 0; b < 2; ++b)
#pragma unroll
            for (int m = 0; m < 4; ++m)
#pragma unroll
                for (int n = 0; n < 2; ++n) acc[a][b][m][n] = (f32x4){0.f, 0.f, 0.f, 0.f};
    bf16x8 At[4][2], B0[2][2], B1[2][2];
    const char* cA = (const char*)g.A + (size_t)cur.pm * tstep; const char* cB = (const char*)g.Bt + (size_t)cur.pn * tstep;
    S.a_ready(cur);
    if constexpr (SP2) {
        PG8_STAGE(PG8_SB(0, 0), cB, voffB); PG8_STAGE(PG8_SB(0, 1), cB + hstep, voffB); PG8_STAGE(PG8_SA(0, 0), cA, voffA); PG8_STAGE(PG8_SA(0, 1), cA + hstep, voffA);
        if (wr == 1) PG8_BAR;
        PG8_WAIT_V(2); PG8_BAR;
        PG8_STAGE(PG8_SB(1, 0), cB + kstep, voffB); PG8_STAGE(PG8_SA(1, 0), cA + kstep, voffA); PG8_STAGE(PG8_SB(1, 1), cB + hstep + kstep, voffB);
        PG8_WAIT_V(6); PG8_BAR;
    } else {
        PG8_STAGE(PG8_SB(0, 0), cB, voffB); PG8_STAGE(PG8_SA(0, 0), cA, voffA); PG8_STAGE(PG8_SB(0, 1), cB + hstep, voffB); PG8_STAGE(PG8_SA(0, 1), cA + hstep, voffA);
        if (wr == 1) PG8_BAR;
        PG8_WAIT_V(4); PG8_BAR;
        PG8_STAGE(PG8_SB(1, 0), cB + kstep, voffB); PG8_STAGE(PG8_SA(1, 0), cA + kstep, voffA); PG8_STAGE(PG8_SB(1, 1), cB + hstep + kstep, voffB);
        PG8_WAIT_V(6); PG8_BAR;
    }
    for (;;) {
        const bool has_next = S.next(ui + 1, nxt);
        const char* nA = has_next ? (const char*)g.A + (size_t)nxt.pm * tstep : cA; const char* nB = has_next ? (const char*)g.Bt + (size_t)nxt.pn * tstep : cB;
        for (int t = 0; t < nt; t += 2) {
            const bool last = (t == nt - 2);
            const char* a1 = cA + (size_t)(t + 1) * kstep;
            const char* a2 = last ? nA : cA + (size_t)(t + 2) * kstep; const char* b2 = last ? nB : cB + (size_t)(t + 2) * kstep;
            const char* a3 = a2 + kstep; const char* b3 = b2 + kstep;
            if (last && has_next) S.a_ready(nxt);
            if constexpr (SP2) {
            PG8_LDB(B0, 0, 0); PG8_LDB(B1, 0, 1); PG8_SCHED; PG8_LDA(At, 0, 0); PG8_STAGE(PG8_SA(1, 1), a1 + hstep, voffA);
            PG8_WAIT_V(8); PG8_WAIT_L(0); PG8_BAR; PG8_MMA(0, 0, At, B0); PG8_MMA(0, 1, At, B1); PG8_BAR; PG8_SCHED;
            PG8_LDA(At, 0, 1); PG8_STAGE(PG8_SB(0, 0), b2, voffB); PG8_STAGE(PG8_SB(0, 1), b2 + hstep, voffB); PG8_STAGE(PG8_SA(0, 0), a2, voffA);
            PG8_WAIT_V(8); PG8_WAIT_L(0); PG8_BAR; PG8_MMA(1, 0, At, B0); PG8_MMA(1, 1, At, B1); PG8_BAR; PG8_SCHED;
            PG8_LDB(B0, 1, 0); PG8_LDB(B1, 1, 1); PG8_SCHED; PG8_LDA(At, 1, 0); PG8_STAGE(PG8_SA(0, 1), a2 + hstep, voffA);
            PG8_WAIT_V(8); PG8_WAIT_L(0); PG8_BAR; PG8_MMA(0, 0, At, B0); PG8_MMA(0, 1, At, B1); PG8_BAR; PG8_SCHED;
            PG8_LDA(At, 1, 1); PG8_STAGE(PG8_SB(1, 0), b3, voffB); PG8_STAGE(PG8_SB(1, 1), b3 + hstep, voffB); PG8_STAGE(PG8_SA(1, 0), a3, voffA);
            PG8_WAIT_V(8); PG8_WAIT_L(0); PG8_BAR; PG8_MMA(1, 0, At, B0); PG8_MMA(1, 1, At, B1); PG8_BAR; PG8_SCHED;
            } else {
            PG8_LDB(B0, 0, 0); PG8_SCHED; PG8_LDA(At, 0, 0); PG8_STAGE(PG8_SA(1, 1), a1 + hstep, voffA);
            PG8_WAIT_L(8); PG8_BAR; PG8_WAIT_L(0); PG8_MMA(0, 0, At, B0); PG8_BAR; PG8_SCHED;
            PG8_LDB(B1, 0, 1); PG8_STAGE(PG8_SB(0, 0), b2, voffB);
            PG8_BAR; PG8_WAIT_L(0); PG8_MMA(0, 1, At, B1); PG8_BAR;
            PG8_LDA(At, 0, 1); PG8_STAGE(PG8_SA(0, 0), a2, voffA);
            PG8_BAR; PG8_WAIT_L(0); PG8_MMA(1, 0, At, B0); PG8_BAR; PG8_SCHED;
            PG8_STAGE(PG8_SB(0, 1), b2 + hstep, voffB);
            PG8_WAIT_V(6); PG8_BAR; PG8_MMA(1, 1, At, B1); PG8_BAR;
            PG8_LDB(B0, 1, 0); PG8_SCHED; PG8_LDA(At, 1, 0); PG8_STAGE(PG8_SA(0, 1), a2 + hstep, voffA);
            PG8_WAIT_L(8); PG8_BAR; PG8_WAIT_L(0); PG8_MMA(0, 0, At, B0); PG8_BAR; PG8_SCHED;
            PG8_LDB(B1, 1, 1); PG8_STAGE(PG8_SB(1, 0), b3, voffB);
            PG8_BAR; PG8_WAIT_L(0); PG8_MMA(0, 1, At, B1); PG8_BAR;
            PG8_LDA(At, 1, 1); PG8_STAGE(PG8_SA(1, 0), a3, voffA);
            PG8_BAR; PG8_WAIT_L(0); PG8_MMA(1, 0, At, B0); PG8_BAR; PG8_SCHED;
            PG8_STAGE(PG8_SB(1, 1), b3 + hstep, voffB);
            PG8_WAIT_V(6); PG8_BAR; PG8_MMA(1, 1, At, B1); PG8_BAR;
            }
        }
        if constexpr (ALIGN_EPI) { if (wr == 0) PG8_BAR; }
        if constexpr (!Epi::AFTER_DRAIN) { E(acc, cur, wr, wc, fr, fq); S.done(cur); }
        if (!has_next) break;
#pragma unroll
        for (int a = 0; a < 2; ++a)
#pragma unroll
            for (int b = 0; b < 2; ++b)
#pragma unroll
                for (int m = 0; m < 4; ++m)
#pragma unroll
                    for (int n = 0; n < 2; ++n) acc[a][b][m][n] = (f32x4){0.f, 0.f, 0.f, 0.f};
        cur = nxt; cA = nA; cB = nB; ++ui;
        if constexpr (ALIGN_EPI) { if (wr == 1) PG8_BAR; }
    }
    PG8_WAIT_V(0);
    if constexpr (!ALIGN_EPI) { if (wr == 0) PG8_BAR; }
    PG8_BAR;
    if constexpr (Epi::AFTER_DRAIN) { E.fused(acc, cur, wr, wc, fr, fq, lds, wid, lane); S.done(cur); }
#undef PG8_SA
#undef PG8_SB
#undef PG8_STAGE
#undef PG8_LDA
#undef PG8_LDB
#undef PG8_MMA
#undef PG8_WAIT_V
#undef PG8_WAIT_L
#undef PG8_BAR
#undef PG8_SCHED
}
}
#ifndef PG8_SP2
#define PG8_SP2 true
#endif
#ifndef PG8_ALIGN
#define PG8_ALIGN true
#endif
#define LAS __attribute__((address_space(3)))
typedef unsigned short bf16;
typedef short bf16x8 __attribute__((ext_vector_type(8)));
typedef float f32x4 __attribute__((ext_vector_type(4)));
typedef float f32x16 __attribute__((ext_vector_type(16)));
typedef unsigned u32x4 __attribute__((ext_vector_type(4)));
typedef unsigned u32x2 __attribute__((ext_vector_type(2)));
constexpr int NB = 8, SEQ = 4096, DM = 1024, T = NB * SEQ, FF = 4096, MEMN = 256, MROWS = NB * MEMN;
constexpr int NA = 1536, NQ = 2048, NINB = 2056;
constexpr float EPS = 1e-6f, LOG2E = 1.4426950408889634f;
constexpr int NWAVES = 8;
constexpr int LDS_BYTES = 147456;
constexpr size_t MiB = 1u << 20;
constexpr size_t WS_CTL = 0; constexpr int BAR_ST_OFF = LDS_BYTES - 256;
constexpr size_t WS_WA = 1 * MiB, WS_WB = 4 * MiB, WS_WF = 8 * MiB, WS_WO = 9 * MiB, WS_W1 = 13 * MiB, WS_W2 = 29 * MiB, WS_WKV = 45 * MiB, WS_WR = 49 * MiB, WS_WI = 49 * MiB + 512 * 1024;
constexpr size_t WS_MEMB = 50 * MiB, WS_MEMSS = 54 * MiB, WS_KVRAW = 55 * MiB, WS_KN = 63 * MiB, WS_VT = 67 * MiB, WS_SSP = 71 * MiB, WS_AP = 73 * MiB, WS_HE = 74 * MiB, WS_CL = 75 * MiB, WS_CTOT = 76 * MiB;
constexpr size_t WS_XB = 80 * MiB, WS_H = 144 * MiB, WS_PROJ = 144 * MiB, WS_CAT = 272 * MiB, WS_QN = 336 * MiB, WS_KNF = 368 * MiB, WS_VTF = 400 * MiB, WS_END = 432 * MiB;

struct Ctx { const float* x; float* out; unsigned char* ws; int vcu, G; };
struct Args { const float* in[23]; float* out; unsigned char* ws; int ph_lo, ph_hi; };
constexpr size_t WS_PAR = 77 * MiB;
constexpr int PQG = 0, PKG = 256, PCW = 512, PCB = 2560, PBR = 3072, PBI = 3584, PLAM = 4096, PBF = 4608, PFQG = 4624, PFKG = 4688, PAR_N = 4752;
#define PHASE_IDS() int tid = threadIdx.x; asm volatile("" : "+v"(tid)); const int lane = tid & 63; const int wid = __builtin_amdgcn_readfirstlane(tid >> 6); unsigned char* ws = C.ws; asm volatile("" : "+s"(ws)); const float* par = (const float*)(ws + WS_PAR)
__device__ __forceinline__ float bf2f(unsigned short b) { return __uint_as_float((unsigned)b << 16); }
typedef __bf16 bf16x2_t __attribute__((ext_vector_type(2))); typedef float f32x2_t __attribute__((ext_vector_type(2)));
__device__ __forceinline__ unsigned pk2(float lo, float hi) { f32x2_t v = {lo, hi}; bf16x2_t b = __builtin_convertvector(v, bf16x2_t); return __builtin_bit_cast(unsigned, b); }
__device__ __forceinline__ unsigned short f2bf(float f) { return (unsigned short)(pk2(f, 0.f) & 0xffffu); }
__device__ __forceinline__ float wave_sum(float v) {
#pragma unroll
    for (int o = 1; o < 64; o <<= 1) v += __shfl_xor(v, o);
    return v;
}
__device__ __forceinline__ float wave_max(float v) {
#pragma unroll
    for (int o = 1; o < 64; o <<= 1) v = fmaxf(v, __shfl_xor(v, o));
    return v;
}
__device__ __forceinline__ int crow(int r, int hi) { return (r & 3) + 8 * (r >> 2) + 4 * hi; }
__device__ __forceinline__ int kperm(int p) { return 8 * ((p & 7) >> 2) + 4 * (p >> 3) + (p & 3); }
__device__ __forceinline__ float sigmoid_f(float x) { return __builtin_amdgcn_rcpf(1.0f + __builtin_amdgcn_exp2f(-LOG2E * x)); }

__device__ __forceinline__ u32x4 ot_pack(const f32x16& o, int k, float rl) {
    const unsigned a0 = pk2(o[8 * k + 0] * rl, o[8 * k + 1] * rl), a1 = pk2(o[8 * k + 2] * rl, o[8 * k + 3] * rl);
    const unsigned b0 = pk2(o[8 * k + 4] * rl, o[8 * k + 5] * rl), b1 = pk2(o[8 * k + 6] * rl, o[8 * k + 7] * rl);
    const auto r0 = __builtin_amdgcn_permlane32_swap(a0, b0, false, false); const auto r1 = __builtin_amdgcn_permlane32_swap(a1, b1, false, false);
    return (u32x4){r0[0], r1[0], r0[1], r1[1]};
}
__device__ __forceinline__ void tr_item(const float* W, int ldw, int col0, bf16* WT, int K, int row0, const float* gain, int kb, int nb, LAS float* scr, int lane) {
    const int k0 = 64 * kb, n0 = 32 * nb;
    float wv[32];
#pragma unroll
    for (int i = 0; i < 32; ++i) { const int kk = 2 * i + (lane >> 5); wv[i] = W[(size_t)(k0 + kk) * ldw + col0 + n0 + (lane & 31)]; }
#pragma unroll
    for (int i = 0; i < 32; ++i) { const int kk = 2 * i + (lane >> 5); const float g = gain ? gain[k0 + kk] : 1.0f; scr[kk * 33 + (lane & 31)] = wv[i] * g; }
    asm volatile("s_waitcnt lgkmcnt(0)" ::: "memory");
    const int c = lane & 7;
#pragma unroll
    for (int j = 0; j < 4; ++j) { const int n = (lane >> 3) + 8 * j; const LAS float* s = scr + (8 * c) * 33 + n;
        u32x4 o; o.x = pk2(s[0 * 33], s[1 * 33]); o.y = pk2(s[2 * 33], s[3 * 33]); o.z = pk2(s[4 * 33], s[5 * 33]); o.w = pk2(s[6 * 33], s[7 * 33]);
        *(u32x4*)(WT + (size_t)(row0 + n0 + n) * K + k0 + 8 * c) = o; }
    asm volatile("s_waitcnt lgkmcnt(0)" ::: "memory");
}
__device__ __forceinline__ void rows4_to_bf16(const float* xrow, bf16* orow, float* ssrow, int lane) {
    f32x4 v[4][4];
#pragma unroll
    for (int r = 0; r < 4; ++r)
#pragma unroll
        for (int j = 0; j < 4; ++j) v[r][j] = ((const f32x4*)(xrow + (size_t)r * DM) + lane)[64 * j];
#pragma unroll
    for (int r = 0; r < 4; ++r) { float s = 0.f;
#pragma unroll
        for (int j = 0; j < 4; ++j) s += (v[r][j][0] * v[r][j][0] + v[r][j][1] * v[r][j][1]) + (v[r][j][2] * v[r][j][2] + v[r][j][3] * v[r][j][3]);
        s = wave_sum(s);
        u32x2* o = (u32x2*)(orow + (size_t)r * DM) + lane;
#pragma unroll
        for (int j = 0; j < 4; ++j) { u32x2 w; w.x = pk2(v[r][j][0], v[r][j][1]); w.y = pk2(v[r][j][2], v[r][j][3]); o[64 * j] = w; }
        if (lane < 16) ssrow[r * 16 + lane] = (lane == 0) ? s : 0.f; }
}
__device__ __forceinline__ void p0_prologue(const Args& A, const Ctx& C, LAS unsigned char* lds) {
    PHASE_IDS();
    LAS float* scr = (LAS float*)(lds + wid * 16384);
    const int gw = C.vcu * NWAVES + wid, NGW = C.G * NWAVES;
    if (C.vcu == 0) { float* pw = (float*)(ws + WS_PAR);
        for (int e = tid; e < PAR_N; e += 512) { float v = 0.f;
            if (e < PKG) v = A.in[5][e - PQG]; else if (e < PCW) v = A.in[6][e - PKG]; else if (e < PCB) v = A.in[12][e - PCW]; else if (e < PBR) v = A.in[13][e - PCB];
            else if (e < PBI) v = A.in[15][e - PBR]; else if (e < PLAM) v = A.in[17][e - PBI]; else if (e < PBF) v = A.in[18][e - PLAM]; else if (e < PBF + 8) v = A.in[20][e - PBF];
            else if (e < PFQG) v = 0.f; else if (e < PFKG) v = A.in[21][e - PFQG]; else v = A.in[22][e - PFKG];
            pw[e] = v; } }
    constexpr int I0 = 16 * 48, I1 = 16 * 48, I2 = 16 * 16, I3 = 16 * 32, I5 = 16 * 128, I7 = 64 * 32, I9 = 16 * 32, I11 = 16;
    constexpr int NITEMS = I0 + I1 + I2 + 2 * I3 + 2 * I5 + 2 * I7 + 2 * I9 + 2 * I11;
    for (int it = gw; it < NITEMS; it += NGW) {
        int r = it;
        if (r < I0) { tr_item(A.in[11], NA, 0, (bf16*)(ws + WS_WA), DM, 0, A.in[2], r / 48, r % 48, scr, lane); continue; } r -= I0;
        if (r < I1) { tr_item(A.in[19], NINB, 0, (bf16*)(ws + WS_WB), DM, 0, A.in[2] + DM, r / 48, r % 48, scr, lane); continue; } r -= I1;
        if (r < I2) { tr_item(A.in[19], NINB, 1544, (bf16*)(ws + WS_WB), DM, 1536, A.in[2] + DM, r / 16, r % 16, scr, lane); continue; } r -= I2;
        if (r < 2 * I3) { const int l = r / I3; r %= I3; tr_item(A.in[7] + (size_t)l * DM * DM, DM, 0, (bf16*)(ws + WS_WO) + (size_t)l * DM * DM, DM, 0, nullptr, r / 32, r % 32, scr, lane); continue; } r -= 2 * I3;
        if (r < 2 * I5) { const int l = r / I5; r %= I5; tr_item(A.in[9] + (size_t)l * DM * FF, FF, 0, (bf16*)(ws + WS_W1) + (size_t)l * DM * FF, DM, 0, A.in[8] + l * DM, r / 128, r % 128, scr, lane); continue; } r -= 2 * I5;
        if (r < 2 * I7) { const int l = r / I7; r %= I7; tr_item(A.in[10] + (size_t)l * DM * FF, DM, 0, (bf16*)(ws + WS_W2) + (size_t)l * DM * FF, FF, 0, nullptr, r / 32, r % 32, scr, lane); continue; } r -= 2 * I7;
        if (r < 2 * I9) { const int l = r / I9; r %= I9; tr_item(A.in[4] + (size_t)l * DM * DM, DM, 0, (bf16*)(ws + WS_WKV) + (size_t)l * DM * DM, DM, 0, A.in[3] + l * DM, r / 32, r % 32, scr, lane); continue; } r -= 2 * I9;
        if (r < I11) { tr_item(A.in[14] + (size_t)(r >> 1) * 4096, 64, 0, (bf16*)(ws + WS_WR) + (size_t)(r >> 1) * 4096, 64, 0, nullptr, 0, r & 1, scr, lane); continue; } r -= I11;
        tr_item(A.in[16] + (size_t)(r >> 1) * 4096, 64, 0, (bf16*)(ws + WS_WI) + (size_t)(r >> 1) * 4096, 64, 0, nullptr, 0, r & 1, scr, lane);
    }
    { bf16* wf = (bf16*)(ws + WS_WF); const float* wb = A.in[19]; const float* g = A.in[2] + DM;
      for (int e = (C.vcu * 512 + tid); e < 16 * DM; e += C.G * 512) { const int n = e >> 10, k = e & 1023; wf[e] = (n < 8) ? f2bf(wb[(size_t)k * NINB + 1536 + n] * g[k]) : (unsigned short)0; } }
    for (int m = 4 * gw; m < T; m += 4 * NGW) rows4_to_bf16(A.in[0] + (size_t)m * DM, (bf16*)(ws + WS_XB) + (size_t)m * DM, (float*)(ws + WS_SSP) + (size_t)m * 16, lane);
    for (int m = 4 * gw; m < MROWS; m += 4 * NGW) rows4_to_bf16(A.in[1] + (size_t)m * DM, (bf16*)(ws + WS_MEMB) + (size_t)m * DM, (float*)(ws + WS_MEMSS) + (size_t)m * 16, lane);
}

template <bool FINAL> __device__ __forceinline__ void lru_unit(const Ctx& C, LAS unsigned char* lds, int b, int ck) {
    PHASE_IDS();
    LAS bf16* UC = (LAS bf16*)lds;
    LAS float* Aa = (LAS float*)(lds + 16640);
    LAS float* Bb = (LAS float*)(lds + 16640 + 32768);
    const bf16* WRt = (const bf16*)(ws + WS_WR) + wid * 4096; const bf16* WIt = (const bf16*)(ws + WS_WI) + wid * 4096;
    bf16x8 br[4][2], bi[4][2];
#pragma unroll
    for (int j = 0; j < 4; ++j)
#pragma unroll
        for (int kk = 0; kk < 2; ++kk) { const int o = (16 * j + (lane & 15)) * 64 + 32 * kk + 8 * (lane >> 4); br[j][kk] = *(const bf16x8*)(WRt + o); bi[j][kk] = *(const bf16x8*)(WIt + o); }
    float cbr[4], cbi[4], csp[4];
#pragma unroll
    for (int j = 0; j < 4; ++j) { const int d = wid * 64 + 16 * j + (lane & 15); cbr[j] = par[PBR + d]; cbi[j] = par[PBI + d];
        const float lam = par[PLAM + d]; const float sp = (lam < -20.f) ? -lam : log1pf(expf(-lam)); csp[j] = 8.0f * sp * LOG2E; }
    const int ch = tid;
    const float cw0 = par[PCW + ch], cw1 = par[PCW + 512 + ch], cw2 = par[PCW + 1024 + ch], cw3 = par[PCW + 1536 + ch], cb = par[PCB + ch];
    const size_t t0 = (size_t)b * SEQ + (size_t)ck * 128;
    const bf16* proj = (const bf16*)(ws + WS_PROJ);
    const bf16* up = proj + t0 * NA + ch;
    float um3 = 0.f, um2 = 0.f, um1 = 0.f;
    if (ck > 0) { um3 = bf2f(*(up - 3 * NA)); um2 = bf2f(*(up - 2 * NA)); um1 = bf2f(*(up - NA)); }
    float h = 0.f, P = 1.f;
    if (FINAL) { const float* ap = (const float*)(ws + WS_AP) + (size_t)b * 32 * 512 + ch; const float* he = (const float*)(ws + WS_HE) + (size_t)b * 32 * 512 + ch;
        for (int k = 0; k < ck; ++k) h = ap[k * 512] * h + he[k * 512]; }
    bf16* cat = (bf16*)(ws + WS_CAT);
    unsigned short un[16], gn[16];
#pragma unroll
    for (int tt = 0; tt < 16; ++tt) { un[tt] = up[(size_t)tt * NA]; if (FINAL) gn[tt] = up[(size_t)tt * NA + 512]; }
#pragma unroll 1
    for (int st = 0; st < 8; ++st) {
        float uc[16], gt[16];
#pragma unroll
        for (int tt = 0; tt < 16; ++tt) { const float u0 = bf2f(un[tt]); uc[tt] = cw0 * um3 + cw1 * um2 + cw2 * um1 + cw3 * u0 + cb; um3 = um2; um2 = um1; um1 = u0; UC[tt * 520 + ch] = f2bf(uc[tt]); if (FINAL) gt[tt] = bf2f(gn[tt]); }
        { const int sn = (st < 7) ? st + 1 : 7;
#pragma unroll
          for (int tt = 0; tt < 16; ++tt) { un[tt] = up[(size_t)(sn * 16 + tt) * NA]; if (FINAL) gn[tt] = up[(size_t)(sn * 16 + tt) * NA + 512]; } }
        __syncthreads();
        { const bf16x8 a0 = *(const LAS bf16x8*)(UC + (lane & 15) * 520 + wid * 64 + 8 * (lane >> 4)), a1 = *(const LAS bf16x8*)(UC + (lane & 15) * 520 + wid * 64 + 32 + 8 * (lane >> 4));
#pragma unroll
          for (int j = 0; j < 4; ++j) {
            f32x4 r = {0.f, 0.f, 0.f, 0.f}, g = {0.f, 0.f, 0.f, 0.f};
            r = __builtin_amdgcn_mfma_f32_16x16x32_bf16(a0, br[j][0], r, 0, 0, 0); r = __builtin_amdgcn_mfma_f32_16x16x32_bf16(a1, br[j][1], r, 0, 0, 0);
            g = __builtin_amdgcn_mfma_f32_16x16x32_bf16(a0, bi[j][0], g, 0, 0, 0); g = __builtin_amdgcn_mfma_f32_16x16x32_bf16(a1, bi[j][1], g, 0, 0, 0);
#pragma unroll
            for (int i = 0; i < 4; ++i) { const int tok = (lane >> 4) * 4 + i; const float rr = sigmoid_f(r[i] + cbr[j]), ii = sigmoid_f(g[i] + cbi[j]);
                const float a = __builtin_amdgcn_exp2f(-rr * csp[j]); const float bb = sqrtf(fmaxf(1.0f - a * a, 0.f)) * ii;
                const int o = tok * 512 + wid * 64 + 16 * j + (lane & 15); Aa[o] = a; Bb[o] = bb; }
          } }
        __syncthreads();
#pragma unroll
        for (int tt = 0; tt < 16; ++tt) { const float a = Aa[tt * 512 + ch], bb = Bb[tt * 512 + ch]; h = a * h + bb * uc[tt];
            if (FINAL) { const size_t t = t0 + st * 16 + tt; cat[t * DM + ch] = f2bf(h * gt[tt]); } else { P *= a; } }
    }
    if (!FINAL) { ((float*)(ws + WS_AP))[((size_t)b * 32 + ck) * 512 + ch] = P; ((float*)(ws + WS_HE))[((size_t)b * 32 + ck) * 512 + ch] = h; }
    __syncthreads();
}

__device__ __forceinline__ void memkv_item(const Ctx& C, int item) {
    PHASE_IDS();
    const int l = item >> 7, b = (item >> 4) & 7, h = (item >> 2) & 3, mg = item & 3;
    const bf16* kvraw = (const bf16*)(ws + WS_KVRAW);
    const float* kg = par + PKG + l * 128;
    const float c2m = LOG2E * 0.08838834764831845f;
    const float g0 = kg[2 * lane] * c2m, g1 = kg[2 * lane + 1] * c2m;
    const size_t hb = (((size_t)l * 8 + b) * 4 + h);
    bf16* kn = (bf16*)(ws + WS_KN) + hb * 256 * 128;
#pragma unroll
    for (int rr = 0; rr < 8; ++rr) { const int m = mg * 64 + wid * 8 + rr;
        const unsigned kv2 = *(const unsigned*)(kvraw + (size_t)(b * 256 + m) * 2048 + l * 1024 + h * 128 + 2 * lane);
        const float k0 = __uint_as_float(kv2 << 16), k1 = __uint_as_float(kv2 & 0xffff0000u);
        const float ss = wave_sum(k0 * k0 + k1 * k1); const float rinv = 1.0f / sqrtf(ss * (1.0f / 128.0f) + EPS);
        *(unsigned*)(kn + (size_t)m * 128 + 2 * lane) = pk2(k0 * rinv * g0, k1 * rinv * g1); }
    { const int d = tid & 127, mq = tid >> 7; unsigned w[8];
      const bf16* vp = kvraw + (size_t)(b * 256 + mg * 64 + mq * 16) * 2048 + l * 1024 + 512 + h * 128 + d;
#pragma unroll
      for (int p = 0; p < 16; p += 2) { const unsigned lo = vp[(size_t)kperm(p) * 2048], hi = vp[(size_t)kperm(p + 1) * 2048]; w[p >> 1] = lo | (hi << 16); }
      bf16* vt = (bf16*)(ws + WS_VT) + (hb * 128 + d) * 256 + mg * 64 + mq * 16;
      *(u32x4*)vt = (u32x4){w[0], w[1], w[2], w[3]}; *(u32x4*)(vt + 8) = (u32x4){w[4], w[5], w[6], w[7]}; }
}

__device__ __forceinline__ void memattn_unit(const Ctx& C, LAS unsigned char* lds, int l, int unit, const bf16* xq, int ldq, int nkb = 8, int pv = 0) {
    PHASE_IDS();
    const int b = unit >> 5, h = (unit >> 3) & 3, tg = unit & 7, r32 = lane & 31, hi = lane >> 5;
    LAS bf16* Ks = (LAS bf16*)lds;
    LAS bf16* Vs = (LAS bf16*)(lds + 69632);
    const size_t hb = (((size_t)l * 8 + b) * 4 + h);
    const bf16* kn = (const bf16*)(ws + WS_KN) + hb * 256 * 128; const bf16* vt = (const bf16*)(ws + WS_VT) + hb * 128 * 256;
    if (pv != 7) {
#pragma unroll
    for (int i = 0; i < 8; ++i) { const int idx = tid + 512 * i; const int row = idx >> 4, c = idx & 15; *(LAS u32x4*)(Ks + row * 136 + c * 8) = *(const u32x4*)(kn + row * 128 + c * 8); }
#pragma unroll
    for (int i = 0; i < 8; ++i) { const int idx = tid + 512 * i; const int row = idx >> 5, c = idx & 31; *(LAS u32x4*)(Vs + row * 264 + c * 8) = *(const u32x4*)(vt + row * 256 + c * 8); }
    }
    const float* qg = par + PQG + l * 128; const float* kg = par + PKG + l * 128;
    const float gq = wave_max(fmaxf(fabsf(qg[2 * lane]), fabsf(qg[2 * lane + 1]))), gk = wave_max(fmaxf(fabsf(kg[2 * lane]), fabsf(kg[2 * lane + 1])));
    const float bound = gq * gk * 11.313708498984761f * LOG2E;
    __syncthreads();
    bf16* cat = (bf16*)(ws + WS_CAT);
#pragma unroll 1
    for (int sub = 0; sub < 2; ++sub) {
        const size_t tok0 = (size_t)b * SEQ + tg * 512 + sub * 256 + wid * 32;
        bf16x8 qf[8];
        { const bf16* qp = xq + (pv == 9 ? (size_t)0 : (tok0 + r32) * ldq) + h * 128 + 8 * hi; float ss = 0.f;
#pragma unroll
          for (int ds = 0; ds < 8; ++ds) { qf[ds] = *(const bf16x8*)(qp + 16 * ds);
#pragma unroll
              for (int j = 0; j < 8; ++j) { const float f = bf2f((unsigned short)qf[ds][j]); ss += f * f; } }
          ss += __shfl_xor(ss, 32); const float rinv = 1.0f / sqrtf(ss * (1.0f / 128.0f) + EPS);
#pragma unroll
          for (int ds = 0; ds < 8; ++ds) { const f32x4 ga = *(const f32x4*)(qg + 16 * ds + 8 * hi), gb = *(const f32x4*)(qg + 16 * ds + 8 * hi + 4);
              unsigned w[4];
#pragma unroll
              for (int j = 0; j < 4; ++j) { const float f0 = bf2f((unsigned short)qf[ds][2 * j]) * rinv * (2 * j < 4 ? ga[(2 * j) & 3] : gb[(2 * j) & 3]);
                  const float f1 = bf2f((unsigned short)qf[ds][2 * j + 1]) * rinv * (2 * j + 1 < 4 ? ga[(2 * j + 1) & 3] : gb[(2 * j + 1) & 3]); w[j] = pk2(f0, f1); }
              qf[ds] = __builtin_bit_cast(bf16x8, (u32x4){w[0], w[1], w[2], w[3]}); } }
        f32x16 o[4]; float lsum = 0.f;
#pragma unroll
        for (int db = 0; db < 4; ++db)
#pragma unroll
            for (int r = 0; r < 16; ++r) o[db][r] = 0.f;
#pragma unroll 1
        for (int kb = 0; kb < nkb; ++kb) {
            f32x16 p0;
#pragma unroll
            for (int r = 0; r < 16; ++r) p0[r] = -bound;
#pragma unroll
            for (int ds = 0; ds < 8; ++ds) { const bf16x8 k0 = *(const LAS bf16x8*)(Ks + (32 * kb + r32) * 136 + 16 * ds + 8 * hi);
                p0 = __builtin_amdgcn_mfma_f32_32x32x16_bf16(k0, qf[ds], p0, 0, 0, 0); if ((ds & 3) == 3) __builtin_amdgcn_sched_barrier(0); }
#pragma unroll
            for (int r = 0; r < 16; ++r) { p0[r] = __builtin_amdgcn_exp2f(p0[r]); lsum += p0[r]; }
            bf16x8 pa[2];
            pa[0] = __builtin_bit_cast(bf16x8, (u32x4){pk2(p0[0], p0[1]), pk2(p0[2], p0[3]), pk2(p0[4], p0[5]), pk2(p0[6], p0[7])});
            pa[1] = __builtin_bit_cast(bf16x8, (u32x4){pk2(p0[8], p0[9]), pk2(p0[10], p0[11]), pk2(p0[12], p0[13]), pk2(p0[14], p0[15])});
#pragma unroll
            for (int db = 0; db < 4; ++db) {
#pragma unroll
                for (int s = 0; s < 2; ++s) { const bf16x8 v = *(const LAS bf16x8*)(Vs + (32 * db + r32) * 264 + 32 * kb + 16 * s + 8 * hi);
                    o[db] = __builtin_amdgcn_mfma_f32_32x32x16_bf16(v, pa[s], o[db], 0, 0, 0); }
                if (db & 1) __builtin_amdgcn_sched_barrier(0); }
        }
        lsum += __shfl_xor(lsum, 32);
        if (pv != 8) { const float rl = __builtin_amdgcn_rcpf(lsum); bf16* op = cat + (tok0 + r32) * DM + 512 + h * 128 + 8 * hi;
#pragma unroll
          for (int db = 0; db < 4; ++db)
#pragma unroll
              for (int k = 0; k < 2; ++k) *(u32x4*)(op + 32 * db + 16 * k) = ot_pack(o[db], k, rl); }
    }
    __syncthreads();
}

__device__ __forceinline__ void foxprep_unit(const Ctx& C, LAS unsigned char* lds, int unit) {
    PHASE_IDS();
    const int b = unit >> 6, ck = unit & 63;
    LAS float* LF = (LAS float*)lds;
    const size_t t0 = (size_t)b * SEQ + (size_t)ck * 64;
    const bf16* proj = (const bf16*)(ws + WS_PROJ);
    if (wid < 4) {
        f32x4 acc = {0.f, 0.f, 0.f, 0.f};
        const bf16* ap = (const bf16*)(ws + WS_XB) + (t0 + 16 * wid + (lane & 15)) * DM + 8 * (lane >> 4);
        const bf16* bp = (const bf16*)(ws + WS_WF) + (size_t)(lane & 15) * DM + 8 * (lane >> 4);
#pragma unroll 16
        for (int ks = 0; ks < 32; ++ks) acc = __builtin_amdgcn_mfma_f32_16x16x32_bf16(*(const bf16x8*)(ap + 32 * ks), *(const bf16x8*)(bp + 32 * ks), acc, 0, 0, 0);
        const int n = lane & 15; const float bfg = par[PBF + n];
#pragma unroll
        for (int i = 0; i < 4; ++i) { const int row = 16 * wid + (lane >> 4) * 4 + i;
            const f32x4* sp = (const f32x4*)((const float*)(ws + WS_SSP) + (t0 + row) * 16); const f32x4 s0 = sp[0], s1 = sp[1], s2 = sp[2], s3 = sp[3];
            const float ss = ((s0[0] + s0[1]) + (s0[2] + s0[3])) + ((s1[0] + s1[1]) + (s1[2] + s1[3])) + ((s2[0] + s2[1]) + (s2[2] + s2[3])) + ((s3[0] + s3[1]) + (s3[2] + s3[3]));
            const float rs = 1.0f / sqrtf(ss * (1.0f / 1024.0f) + EPS);
            const float logit = acc[i] * rs + bfg;
            const float lf = -__builtin_amdgcn_logf(1.0f + __builtin_amdgcn_exp2f(-LOG2E * logit));
            if (n < 8) LF[row * 8 + n] = lf; }
    }
    { const float c2f = 0.125f * LOG2E;
#pragma unroll 4
      for (int jb = wid; jb < 128; jb += 8) { const int which = jb >> 6; const size_t tok = t0 + (jb & 63);
        const bf16x8 v = *(const bf16x8*)(proj + tok * NQ + which * 512 + 8 * lane); float f[8]; float ss = 0.f;
#pragma unroll
        for (int j = 0; j < 8; ++j) { f[j] = bf2f((unsigned short)v[j]); ss += f[j] * f[j]; }
        ss += __shfl_xor(ss, 1); ss += __shfl_xor(ss, 2); ss += __shfl_xor(ss, 4);
        const float rinv = (1.0f / sqrtf(ss * (1.0f / 64.0f) + EPS)) * (which ? 1.0f : c2f);
        const float* gp = par + (which ? PFKG : PFQG) + ((8 * lane) & 63); const f32x4 ga = *(const f32x4*)gp, gb = *(const f32x4*)(gp + 4);
        u32x4 w; w.x = pk2(f[0] * rinv * ga[0], f[1] * rinv * ga[1]); w.y = pk2(f[2] * rinv * ga[2], f[3] * rinv * ga[3]); w.z = pk2(f[4] * rinv * gb[0], f[5] * rinv * gb[1]); w.w = pk2(f[6] * rinv * gb[2], f[7] * rinv * gb[3]);
        *(u32x4*)((bf16*)(ws + (which ? WS_KNF : WS_QN)) + tok * 512 + 8 * lane) = w; } }
    { const int hd = tid; bf16* vtf = (bf16*)(ws + WS_VTF) + (((size_t)b * 8 + (hd >> 6)) * 64 + (hd & 63)) * SEQ + (size_t)ck * 64;
#pragma unroll 2
      for (int g = 0; g < 4; ++g) { unsigned w[8]; const bf16* vp = proj + (t0 + 16 * g) * NQ + 1024 + hd;
#pragma unroll
        for (int p = 0; p < 16; p += 2) { const unsigned lo = vp[(size_t)kperm(p) * NQ], hi = vp[(size_t)kperm(p + 1) * NQ]; w[p >> 1] = lo | (hi << 16); }
        *(u32x4*)(vtf + 16 * g) = (u32x4){w[0], w[1], w[2], w[3]}; *(u32x4*)(vtf + 16 * g + 8) = (u32x4){w[4], w[5], w[6], w[7]}; } }
    __syncthreads();
    if (tid < 8) { float c = 0.f; float* cl = (float*)(ws + WS_CL) + ((size_t)b * 8 + tid) * SEQ + (size_t)ck * 64;
        for (int row = 0; row < 64; ++row) { c += LF[row * 8 + tid]; cl[row] = c; }
        ((float*)(ws + WS_CTOT))[((size_t)b * 8 + tid) * 64 + ck] = c; }
    __syncthreads();
}

__device__ __forceinline__ void fox_unit(const Ctx& C, LAS unsigned char* lds, int b, int h, int qb) {
    PHASE_IDS();
    const int r32 = lane & 31, hi = lane >> 5;
    LAS bf16* Ks = (LAS bf16*)lds;
    LAS bf16* Vs = (LAS bf16*)(lds + 9216);
    LAS float* CJ = (LAS float*)(lds + 18432);
    LAS float* COF = (LAS float*)(lds + 18688);
    const size_t bh = (size_t)b * 8 + h;
    const float* cl = (const float*)(ws + WS_CL) + bh * SEQ;
    if (wid == 0) { const float own = ((const float*)(ws + WS_CTOT))[bh * 64 + lane]; float v = own;
#pragma unroll
        for (int o = 1; o < 64; o <<= 1) { const float t = __shfl_up(v, o); if (lane >= o) v += t; }
        COF[lane] = v - own; }
    const float* qg = par + PFQG; const float* kg = par + PFKG;
    const float gq = wave_max(fabsf(qg[lane])), gk = wave_max(fabsf(kg[lane]));
    const float bound = 8.0f * gq * gk * LOG2E;
    __syncthreads();
    const float base = COF[4 * qb];
    const int q0 = 256 * qb, qw0 = q0 + 32 * wid, qrow = qw0 + r32;
    const float ci = cl[qrow] + (COF[qrow >> 6] - base) - bound;
    bf16x8 qf[4];
    { const bf16* qp = (const bf16*)(ws + WS_QN) + ((size_t)b * SEQ + qrow) * 512 + h * 64 + 8 * hi;
#pragma unroll
      for (int ds = 0; ds < 4; ++ds) qf[ds] = *(const bf16x8*)(qp + 16 * ds); }
    const int NT = 4 * (qb + 1);
    const bf16* kp = (const bf16*)(ws + WS_KNF) + ((size_t)b * SEQ + (tid >> 3)) * 512 + h * 64 + (tid & 7) * 8;
    const bf16* vp = (const bf16*)(ws + WS_VTF) + (bh * 64 + (tid >> 3)) * SEQ + (tid & 7) * 8;
    u32x4 kreg = *(const u32x4*)kp, vreg = *(const u32x4*)vp; float cjreg = (tid < 64) ? cl[tid] : 0.f;
    f32x16 o[2]; float lsum = 0.f;
#pragma unroll
    for (int r = 0; r < 16; ++r) { o[0][r] = 0.f; o[1][r] = 0.f; }
    for (int j = 0; j < NT; ++j) {
        __syncthreads();
        *(LAS u32x4*)(Ks + (tid >> 3) * 72 + (tid & 7) * 8) = kreg; *(LAS u32x4*)(Vs + (tid >> 3) * 72 + (tid & 7) * 8) = vreg;
        if (tid < 64) CJ[tid] = cjreg + (COF[j] - base);
        __syncthreads();
        if (j + 1 < NT) { kreg = *(const u32x4*)(kp + (size_t)(j + 1) * 64 * 512); vreg = *(const u32x4*)(vp + (j + 1) * 64); if (tid < 64) cjreg = cl[(j + 1) * 64 + tid]; }
        if (64 * j <= qw0 + 31) {
            f32x16 p0, p1;
#pragma unroll
            for (int g = 0; g < 4; ++g) { const f32x4 c0 = *(const LAS f32x4*)(CJ + 8 * g + 4 * hi), c1 = *(const LAS f32x4*)(CJ + 32 + 8 * g + 4 * hi);
#pragma unroll
                for (int e = 0; e < 4; ++e) { p0[4 * g + e] = ci - c0[e]; p1[4 * g + e] = ci - c1[e]; } }
            if (64 * j + 63 > qw0) {
#pragma unroll
                for (int r = 0; r < 16; ++r) { const int kv = 64 * j + crow(r, hi); if (kv > qrow) p0[r] = -INFINITY; if (kv + 32 > qrow) p1[r] = -INFINITY; } }
#pragma unroll
            for (int ds = 0; ds < 4; ++ds) { const bf16x8 k0 = *(const LAS bf16x8*)(Ks + r32 * 72 + 16 * ds + 8 * hi), k1 = *(const LAS bf16x8*)(Ks + (32 + r32) * 72 + 16 * ds + 8 * hi);
                p0 = __builtin_amdgcn_mfma_f32_32x32x16_bf16(k0, qf[ds], p0, 0, 0, 0); p1 = __builtin_amdgcn_mfma_f32_32x32x16_bf16(k1, qf[ds], p1, 0, 0, 0); }
#pragma unroll
            for (int r = 0; r < 16; ++r) { p0[r] = __builtin_amdgcn_exp2f(p0[r]); p1[r] = __builtin_amdgcn_exp2f(p1[r]); lsum += p0[r] + p1[r]; }
            bf16x8 pa[4];
            pa[0] = __builtin_bit_cast(bf16x8, (u32x4){pk2(p0[0], p0[1]), pk2(p0[2], p0[3]), pk2(p0[4], p0[5]), pk2(p0[6], p0[7])});
            pa[1] = __builtin_bit_cast(bf16x8, (u32x4){pk2(p0[8], p0[9]), pk2(p0[10], p0[11]), pk2(p0[12], p0[13]), pk2(p0[14], p0[15])});
            pa[2] = __builtin_bit_cast(bf16x8, (u32x4){pk2(p1[0], p1[1]), pk2(p1[2], p1[3]), pk2(p1[4], p1[5]), pk2(p1[6], p1[7])});
            pa[3] = __builtin_bit_cast(bf16x8, (u32x4){pk2(p1[8], p1[9]), pk2(p1[10], p1[11]), pk2(p1[12], p1[13]), pk2(p1[14], p1[15])});
#pragma unroll
            for (int db = 0; db < 2; ++db)
#pragma unroll
                for (int s = 0; s < 4; ++s) { const bf16x8 v = *(const LAS bf16x8*)(Vs + (32 * db + r32) * 72 + 16 * s + 8 * hi);
                    o[db] = __builtin_amdgcn_mfma_f32_32x32x16_bf16(v, pa[s], o[db], 0, 0, 0); }
        }
    }
    lsum += __shfl_xor(lsum, 32);
    { const float rl = __builtin_amdgcn_rcpf(lsum); bf16* op = (bf16*)(ws + WS_CAT) + ((size_t)b * SEQ + qrow) * DM + h * 64 + 8 * hi;
#pragma unroll
      for (int db = 0; db < 2; ++db)
#pragma unroll
          for (int k = 0; k < 2; ++k) *(u32x4*)(op + 32 * db + 16 * k) = ot_pack(o[db], k, rl); }
    __syncthreads();
}

#define XB_TMO      128
#define XB_XCNT(j)  (256  + 64 * (j))
#define XB_XSUB(j)  (1280 + 64 * (j))
#define XB_XGEN(j)  (2304 + 64 * (j))
#define XB_TOP      3328
#define XB_TOPGEN   3392
#define XCD_BAR_WORDS 3456
#define XB_SPIN_CAP (1u << 18)

__device__ __forceinline__ unsigned xb_ld(unsigned* p)              { return __hip_atomic_load(p, __ATOMIC_RELAXED, __HIP_MEMORY_SCOPE_AGENT); }
__device__ __forceinline__ unsigned xb_add(unsigned* p, unsigned v) { return __hip_atomic_fetch_add(p, v, __ATOMIC_RELAXED, __HIP_MEMORY_SCOPE_AGENT); }
__device__ __forceinline__ unsigned xb_xcc_id() { return (unsigned)__builtin_amdgcn_s_getreg((3 << 11) | 20) & 0xFu; }
#define XB_SPIN(cond, bar) do { unsigned _sp = 0; while (cond) { __builtin_amdgcn_s_sleep(1); \
    if ((++_sp & 255u) == 0u) { if (xb_ld(&(bar)[XB_TMO])) break; if (_sp > XB_SPIN_CAP) { atomicAdd(&(bar)[XB_TMO], 1u); break; } } } } while (0)

struct XcdBarrier {
    unsigned* bar; unsigned x;
    volatile LAS unsigned* st;
};

__device__ __forceinline__ XcdBarrier xcd_barrier_post(unsigned* bar, volatile LAS unsigned* st) {
    XcdBarrier b; b.bar = bar; b.x = xb_xcc_id(); b.st = st;
    if (threadIdx.x == 0) (void)xb_add(&bar[XB_XCNT(b.x)], 1u);
    return b;
}
__device__ __forceinline__ void xcd_barrier_complete(unsigned* bar, unsigned x, unsigned& nloc, unsigned& nx) {
    const unsigned G = gridDim.x * gridDim.y * gridDim.z;
    unsigned sum, cnt, mine, sp = 0u;
    for (;;) {
        sum = 0u; cnt = 0u; mine = 0u;
#pragma unroll
        for (unsigned j = 0; j < 16; ++j) { const unsigned c = xb_ld(&bar[XB_XCNT(j)]); sum += c; cnt += (c > 0u) ? 1u : 0u; mine = (j == x) ? c : mine; }
        if (sum == G) break;
        __builtin_amdgcn_s_sleep(1);
        if ((++sp & 255u) == 0u) { if (xb_ld(&bar[XB_TMO])) break; if (sp > XB_SPIN_CAP) { atomicAdd(&bar[XB_TMO], 1u); break; } }
    }
    nloc = mine > 0u ? mine : 1u; nx = cnt > 0u ? cnt : 1u;
}

__device__ __forceinline__ void xcd_barrier(const XcdBarrier& b) {
    asm volatile("s_waitcnt vmcnt(0)" ::: "memory");
    __syncthreads();
    if (threadIdx.x == 0) {
        unsigned* bar = b.bar;
        __builtin_amdgcn_s_waitcnt(0);
        unsigned nloc = b.st[0], nx = b.st[1];
        if (nloc == 0u) { xcd_barrier_complete(bar, b.x, nloc, nx); b.st[0] = nloc; b.st[1] = nx; }
        const unsigned old = xb_add(&bar[XB_XSUB(b.x)], 1u);
        const unsigned gen = old / nloc;
        if (old + 1u == (gen + 1u) * nloc) {
            __builtin_amdgcn_fence(__ATOMIC_RELEASE, "agent");
            asm volatile("s_waitcnt vmcnt(0)" ::: "memory");
            const unsigned og = xb_add(&bar[XB_TOP], 1u);
            const unsigned tg = og / nx;
            if (og + 1u == (tg + 1u) * nx) xb_add(&bar[XB_TOPGEN], 1u);
            else XB_SPIN(xb_ld(&bar[XB_TOPGEN]) == tg, bar);
            __builtin_amdgcn_fence(__ATOMIC_ACQUIRE, "agent");
            xb_add(&bar[XB_XGEN(b.x)], 1u);
            asm volatile("s_waitcnt vmcnt(0)" ::: "memory");
        } else {
            XB_SPIN(xb_ld(&bar[XB_XGEN(b.x)]) == gen, bar);
            __builtin_amdgcn_fence(__ATOMIC_ACQUIRE, "agent");
            asm volatile("s_waitcnt vmcnt(0)" ::: "memory");
        }
    }
    __syncthreads();
}

constexpr int NPHASE = 13;
__global__ void __launch_bounds__(NWAVES * 64, 2) fwd_kernel(Args args) {
    extern __shared__ __attribute__((aligned(16))) unsigned char lds_raw[];
    LAS unsigned char* lds = (LAS unsigned char*)lds_raw;
    Ctx C;
    C.x = args.in[0]; C.out = args.out; C.ws = args.ws;
    C.G = gridDim.x; { const int bx = blockIdx.x; C.vcu = (C.G % 8 == 0) ? (bx % 8) * (C.G / 8) + bx / 8 : bx; }
    unsigned char* ws = args.ws;
    const int lo = args.ph_lo, hi = args.ph_hi;
    if (threadIdx.x < 4) ((LAS unsigned*)(lds + BAR_ST_OFF))[threadIdx.x] = 0u;
    __syncthreads();
    XcdBarrier bar = xcd_barrier_post((unsigned*)(ws + WS_CTL), (volatile LAS unsigned*)(lds + BAR_ST_OFF));
#ifndef PROBE_SUB
#define PROBE_SUB 0
#endif
#ifndef PHASE_MASK
#define PHASE_MASK 0x1fff
#endif
#define IN(k) (((PHASE_MASK >> (k)) & 1) && lo <= (k) && (k) < hi)
#define SEAM(k) do { if (IN(k) && IN((k) + 1)) { if ((k) == 0) cg::this_grid().sync(); else xcd_barrier(bar); } } while (0)
    bf16* XB = (bf16*)(ws + WS_XB); float* SSP = (float*)(ws + WS_SSP); bf16* PROJ = (bf16*)(ws + WS_PROJ); bf16* CAT = (bf16*)(ws + WS_CAT); bf16* HB = (bf16*)(ws + WS_H);

    if (IN(0)) { p0_prologue(args, C, lds); } SEAM(0);
    if (IN(1)) {
        { pg8::Gemm g{(const bf16*)(ws + WS_MEMB), (const bf16*)(ws + WS_WKV), MROWS, 2048, DM}; pg8::StaticOrder S; S.init(MROWS, 2048, C.G, (int)blockIdx.x);
          pg8::EpiAct<0> E{(bf16*)(ws + WS_KVRAW), 2048, (const float*)(ws + WS_MEMSS), 1.0f / DM, EPS};
          pg8::gemm_phase<pg8::EpiAct<0>, pg8::StaticOrder, PG8_ALIGN, PG8_SP2>(lds, g, S, E); }
        { pg8::Gemm g{XB, (const bf16*)(ws + WS_WA), T, NA, DM}; pg8::StaticOrder S; S.init(T, NA, C.G, (int)blockIdx.x);
          pg8::EpiAct<1> E{PROJ, NA, SSP, 1.0f / DM, EPS};
          pg8::gemm_phase<pg8::EpiAct<1>, pg8::StaticOrder, PG8_ALIGN, PG8_SP2>(lds, g, S, E); }
    } SEAM(1);
    if (IN(2)) {
        for (int rr = 0; rr < (PROBE_SUB == 3 ? 2 : 1); ++rr)
        for (int u = C.vcu; u < 256; u += C.G) memkv_item(C, u);
        for (int u = C.vcu; u < 256; u += C.G) lru_unit<false>(C, lds, u >> 5, u & 31);
    } SEAM(2);
    if (IN(3)) {
        for (int rr = 0; rr < (PROBE_SUB == 1 ? 2 : 1); ++rr)
        for (int u = C.vcu; u < 256; u += C.G) lru_unit<true>(C, lds, u >> 5, u & 31);
        if (PROBE_SUB == 5) { int z = 0; asm volatile("" : "+s"(z)); for (int u = C.vcu; u < 256; u += C.G) memattn_unit(C, lds, 0, u, PROJ + 1024, NA, z); }
        if (PROBE_SUB >= 7) { int z = 0, pvv = PROBE_SUB; asm volatile("" : "+s"(z), "+s"(pvv)); for (int u = C.vcu; u < 256; u += C.G) memattn_unit(C, lds, 0, u, PROJ + 1024, NA, z, pvv); }
        if (PROBE_SUB == 6) { for (int u = C.vcu; u < 256; u += C.G) memattn_unit(C, lds, 0, u, PROJ + 1024, NA); }
        for (int u = C.vcu; u < 256; u += C.G) memattn_unit(C, lds, 0, u, PROJ + 1024, NA);
    } SEAM(3);
    if (IN(4)) { pg8::Gemm g{CAT, (const bf16*)(ws + WS_WO), T, DM, DM}; pg8::StaticOrder S; S.init(T, DM, C.G, (int)blockIdx.x);
        pg8::EpiResB<true, false> E{C.x, XB, SSP, C.out, DM};
        pg8::gemm_phase<pg8::EpiResB<true, false>, pg8::StaticOrder, PG8_ALIGN, PG8_SP2>(lds, g, S, E); } SEAM(4);
    if (IN(5)) { pg8::Gemm g{XB, (const bf16*)(ws + WS_W1), T, FF, DM}; pg8::StaticOrder S; S.init(T, FF, C.G, (int)blockIdx.x);
        pg8::EpiAct<2> E{HB, FF, SSP, 1.0f / DM, EPS};
        pg8::gemm_phase<pg8::EpiAct<2>, pg8::StaticOrder, PG8_ALIGN, PG8_SP2>(lds, g, S, E); } SEAM(5);
    if (IN(6)) { pg8::Gemm g{HB, (const bf16*)(ws + WS_W2), T, DM, FF}; pg8::StaticOrder S; S.init(T, DM, C.G, (int)blockIdx.x);
        pg8::EpiResB<false, false> E{nullptr, XB, SSP, C.out, DM};
        pg8::gemm_phase<pg8::EpiResB<false, false>, pg8::StaticOrder, PG8_ALIGN, PG8_SP2>(lds, g, S, E); } SEAM(6);
    if (IN(7)) { pg8::Gemm g{XB, (const bf16*)(ws + WS_WB), T, NQ, DM}; pg8::StaticOrder S; S.init(T, NQ, C.G, (int)blockIdx.x);
        pg8::EpiAct<0> E{PROJ, NQ, SSP, 1.0f / DM, EPS};
        pg8::gemm_phase<pg8::EpiAct<0>, pg8::StaticOrder, PG8_ALIGN, PG8_SP2>(lds, g, S, E); } SEAM(7);
    if (IN(8)) {
        for (int rr = 0; rr < (PROBE_SUB == 2 ? 2 : 1); ++rr)
        for (int u = C.vcu; u < 512; u += C.G) foxprep_unit(C, lds, u);
        for (int u = C.vcu; u < 256; u += C.G) memattn_unit(C, lds, 1, u, PROJ + 1536, NQ);
    } SEAM(8);
    if (IN(9)) {
        for (int u = C.vcu; u < 1024; u += C.G) { const int i = u / C.G, v = u % C.G; int bh, qb;
            if (C.G == 256) { const int s = v & 3; bh = v >> 2; qb = (i == 0) ? s : (i == 1) ? 7 - s : (i == 2) ? 8 + s : 15 - s; } else { bh = u >> 4; qb = u & 15; }
            fox_unit(C, lds, bh >> 3, bh & 7, qb); }
    } SEAM(9);
    if (IN(10)) { pg8::Gemm g{CAT, (const bf16*)(ws + WS_WO) + (size_t)DM * DM, T, DM, DM}; pg8::StaticOrder S; S.init(T, DM, C.G, (int)blockIdx.x);
        pg8::EpiResB<false, false> E{nullptr, XB, SSP, C.out, DM};
        pg8::gemm_phase<pg8::EpiResB<false, false>, pg8::StaticOrder, PG8_ALIGN, PG8_SP2>(lds, g, S, E); } SEAM(10);
    if (IN(11)) { pg8::Gemm g{XB, (const bf16*)(ws + WS_W1) + (size_t)DM * FF, T, FF, DM}; pg8::StaticOrder S; S.init(T, FF, C.G, (int)blockIdx.x);
        pg8::EpiAct<2> E{HB, FF, SSP, 1.0f / DM, EPS};
        pg8::gemm_phase<pg8::EpiAct<2>, pg8::StaticOrder, PG8_ALIGN, PG8_SP2>(lds, g, S, E); } SEAM(11);
    if (IN(12)) { pg8::Gemm g{HB, (const bf16*)(ws + WS_W2) + (size_t)DM * FF, T, DM, FF}; pg8::StaticOrder S; S.init(T, DM, C.G, (int)blockIdx.x);
        pg8::EpiResB<false, true> E{nullptr, XB, SSP, C.out, DM};
        pg8::gemm_phase<pg8::EpiResB<false, true>, pg8::StaticOrder, PG8_ALIGN, PG8_SP2>(lds, g, S, E); }
#undef IN
#undef SEAM
}

extern "C" void kernel_launch(void* const* d_in, const int* in_sizes, int n_in, void* d_out, int out_size, void* d_ws, size_t ws_size, hipStream_t stream) {
    static int grid = 0;
    if (grid == 0) {
        if (n_in != 23 || in_sizes[0] != T * DM || out_size != T * DM || ws_size < WS_END) { fprintf(stderr, "kernel_launch: unexpected shapes (n_in %d, in0 %d, out %d, ws %zu)\n", n_in, n_in > 0 ? in_sizes[0] : -1, out_size, ws_size); grid = -1; return; }
        int dev = 0, cus = 0, per_cu = 0;
        if (hipGetDevice(&dev) != hipSuccess || hipDeviceGetAttribute(&cus, hipDeviceAttributeMultiprocessorCount, dev) != hipSuccess) { grid = -1; return; }
        if (hipFuncSetAttribute((const void*)fwd_kernel, hipFuncAttributeMaxDynamicSharedMemorySize, LDS_BYTES) != hipSuccess) { fprintf(stderr, "kernel_launch: hipFuncSetAttribute failed\n"); grid = -1; return; }
        if (hipOccupancyMaxActiveBlocksPerMultiprocessor(&per_cu, (const void*)fwd_kernel, NWAVES * 64, LDS_BYTES) != hipSuccess || per_cu < 1) { fprintf(stderr, "kernel_launch: occupancy query says %d\n", per_cu); per_cu = 1; }
        (void)hipGetLastError();
        grid = cus;
    }
    if (grid < 0) return;
    Args a{};
    for (int i = 0; i < 23; ++i) a.in[i] = (const float*)d_in[i];
    a.out = (float*)d_out; a.ws = (unsigned char*)d_ws;
#if MK_MULTI
#ifndef REP_MASK
#define REP_MASK 0
#endif
    for (int p = 0; p < NPHASE; ++p) { a.ph_lo = p; a.ph_hi = p + 1; const int reps = ((REP_MASK >> p) & 1) ? 2 : 1;
        for (int r = 0; r < reps; ++r) hipLaunchKernelGGL(fwd_kernel, dim3(grid), dim3(NWAVES * 64), LDS_BYTES, stream, a); }
#else
    a.ph_lo = 0; a.ph_hi = NPHASE;
    if (hipMemsetAsync((char*)d_ws + WS_CTL, 0, 16384, stream) != hipSuccess) { fprintf(stderr, "kernel_launch: memset failed\n"); return; }
    void* kargs[] = {&a};
    hipError_t e = hipLaunchCooperativeKernel((const void*)fwd_kernel, dim3(grid), dim3(NWAVES * 64), kargs, LDS_BYTES, stream);
    if (e != hipSuccess) fprintf(stderr, "kernel_launch: cooperative launch failed: %s (grid %d)\n", hipGetErrorString(e), grid);
#endif
}
```
